# Optimizing an MI355X kernel written in HIP

```python
import math
import jax, jax.numpy as jnp
from jax import lax
import numpy as np

D_MODEL = 4096
BATCH = 4
SEQ = 4096
DEPTH = 1

HEAD_DIM = 128
N_MOBA_HEADS = D_MODEL // (2 * HEAD_DIM)
N_SB_HEADS = D_MODEL // (2 * HEAD_DIM)
MOBA_WIDTH = N_MOBA_HEADS * HEAD_DIM
SB_WIDTH = N_SB_HEADS * HEAD_DIM
MIX_WIDTH = MOBA_WIDTH + SB_WIDTH
MOBA_BLOCK = 256
MOBA_TOPK = 3
MOBA_Q_CHUNK = 16
SB_Q_BLOCK = 128
N_MEM = 256
N_XATTN_HEADS = 4
XATTN_WIDTH = N_XATTN_HEADS * HEAD_DIM
PEER_HEADS = 8
PEER_N_KEYS = 128
PEER_N_EXPERTS = PEER_N_KEYS * PEER_N_KEYS
PEER_KEY_DIM = 256
PEER_HALF = PEER_KEY_DIM // 2
PEER_TOPK = 16
RMS_EPS = 1e-6
NEG_INF = -1e30

kernel_name = 'hybrid_moba_stickbreaking_peer_layer'


def rmsnorm(x, g):
    xf = x.astype(jnp.float32)
    y = xf * lax.rsqrt(jnp.mean(xf * xf, axis=-1, keepdims=True) + RMS_EPS)
    return (y * g.astype(jnp.float32)).astype(x.dtype)


def alibi_slopes(n_heads):
    return jnp.asarray(2.0 ** (-8.0 * np.arange(1, n_heads + 1) / n_heads), dtype=jnp.float32)


def split_heads(t, n_heads):
    b, s, _ = t.shape
    return t.reshape(b, s, n_heads, HEAD_DIM).transpose(0, 2, 1, 3)


def merge_heads(t):
    b, h, s, d = t.shape
    return t.transpose(0, 2, 1, 3).reshape(b, s, h * d)


def moba_attention(q, k, v, slopes):
    B, H, T, Dh = q.shape
    nb = -(-T // MOBA_BLOCK)
    pad = nb * MOBA_BLOCK - T
    k_blocks = jnp.pad(k, ((0, 0), (0, 0), (0, pad), (0, 0))).reshape(B, H, nb, MOBA_BLOCK, Dh)
    v_blocks = jnp.pad(v, ((0, 0), (0, 0), (0, pad), (0, 0))).reshape(B, H, nb, MOBA_BLOCK, Dh)
    k_mean = jnp.mean(k_blocks.astype(jnp.float32), axis=3)
    scale = Dh ** -0.5
    k_eff = min(MOBA_TOPK, nb)
    b_idx = jnp.arange(B)[:, None, None, None]
    h_idx = jnp.arange(H)[None, :, None, None]
    blk_pos = jnp.arange(MOBA_BLOCK)
    n_chunks = T // MOBA_Q_CHUNK

    def chunk(c):
        t0 = c * MOBA_Q_CHUNK
        q_c = lax.dynamic_slice_in_dim(q, t0, MOBA_Q_CHUNK, axis=2)
        t_pos = t0 + jnp.arange(MOBA_Q_CHUNK)
        own = t0 // MOBA_BLOCK
        gate = jnp.einsum('bhqd,bhnd->bhqn', q_c.astype(jnp.float32), k_mean)
        gate = jnp.where(jnp.arange(nb) < own, gate, NEG_INF)
        _, sel = lax.top_k(gate, k_eff)
        sel_valid = jnp.arange(k_eff) < own
        k_sel = k_blocks[b_idx, h_idx, sel]
        v_sel = v_blocks[b_idx, h_idx, sel]
        s_sel = jnp.einsum('bhqd,bhqkjd->bhqkj', q_c, k_sel).astype(jnp.float32) * scale
        dist_sel = (t_pos[:, None, None] - (sel[..., None] * MOBA_BLOCK + blk_pos)).astype(jnp.float32)
        s_sel = s_sel - slopes[:, None, None, None] * dist_sel
        s_sel = jnp.where(sel_valid[:, None], s_sel, NEG_INF)
        s_sel = s_sel.reshape(B, H, MOBA_Q_CHUNK, k_eff * MOBA_BLOCK)
        k_own = lax.dynamic_index_in_dim(k_blocks, own, axis=2, keepdims=False)
        v_own = lax.dynamic_index_in_dim(v_blocks, own, axis=2, keepdims=False)
        s_own = jnp.einsum('bhqd,bhjd->bhqj', q_c, k_own).astype(jnp.float32) * scale
        dist_own = t_pos[:, None] - (own * MOBA_BLOCK + blk_pos)[None, :]
        s_own = s_own - slopes[:, None, None] * dist_own.astype(jnp.float32)
        s_own = jnp.where(dist_own >= 0, s_own, NEG_INF)
        p = jax.nn.softmax(jnp.concatenate([s_sel, s_own], axis=-1), axis=-1)
        p_sel = p[..., : k_eff * MOBA_BLOCK].reshape(B, H, MOBA_Q_CHUNK, k_eff, MOBA_BLOCK)
        p_own = p[..., k_eff * MOBA_BLOCK:]
        return (jnp.einsum('bhqkj,bhqkjd->bhqd', p_sel.astype(v.dtype), v_sel)
                + jnp.einsum('bhqj,bhjd->bhqd', p_own.astype(v.dtype), v_own))

    o = lax.map(chunk, jnp.arange(n_chunks))
    return jnp.moveaxis(o, 0, 2).reshape(B, H, T, Dh)


def stick_breaking_attention(q, k, v):
    B, H, T, Dh = q.shape
    scale = Dh ** -0.5
    key_pos = jnp.arange(T)
    n_blocks = T // SB_Q_BLOCK

    def block(c):
        t0 = c * SB_Q_BLOCK
        q_c = lax.dynamic_slice_in_dim(q, t0, SB_Q_BLOCK, axis=2)
        t_pos = t0 + jnp.arange(SB_Q_BLOCK)
        z = jnp.einsum('bhqd,bhsd->bhqs', q_c, k).astype(jnp.float32) * scale
        strict = key_pos[None, :] < t_pos[:, None]
        log_beta = jax.nn.log_sigmoid(z)
        log_one_minus = jnp.where(strict, jax.nn.log_sigmoid(-z), 0.0)
        log_remain = lax.cumsum(log_one_minus, axis=3, reverse=True) - log_one_minus
        a = jnp.where(strict, jnp.exp(log_beta + log_remain), 0.0)
        return jnp.einsum('bhqs,bhsd->bhqd', a.astype(v.dtype), v)

    o = lax.map(block, jnp.arange(n_blocks))
    return jnp.moveaxis(o, 0, 2).reshape(B, H, T, Dh)


def cross_attention(h, mem_n, w_xq, w_xkv, q_norm_g, k_norm_g, w_xo):
    B, T, _ = h.shape
    M = mem_n.shape[1]
    q = rmsnorm((h @ w_xq).reshape(B, T, N_XATTN_HEADS, HEAD_DIM), q_norm_g)
    kv = mem_n @ w_xkv
    k = rmsnorm(kv[..., :XATTN_WIDTH].reshape(B, M, N_XATTN_HEADS, HEAD_DIM), k_norm_g)
    v = kv[..., XATTN_WIDTH:].reshape(B, M, N_XATTN_HEADS, HEAD_DIM)
    s = jnp.einsum('bthd,bmhd->bhtm', q, k).astype(jnp.float32) * (HEAD_DIM ** -0.5)
    p = jax.nn.softmax(s, axis=-1)
    o = jnp.einsum('bhtm,bmhd->bthd', p.astype(v.dtype), v).reshape(B, T, XATTN_WIDTH)
    return o @ w_xo


def peer_ffn(h, w_q, sub_keys, u, v):
    B, T, D = h.shape
    n_tok = B * T
    hf = h.reshape(n_tok, D)
    q = (hf @ w_q).reshape(n_tok, PEER_HEADS, 2, PEER_HALF)
    s = jnp.einsum('nhpc,hpkc->nhpk', q, sub_keys).astype(jnp.float32)
    val, idx = lax.top_k(s, PEER_TOPK)
    cand = val[:, :, 0, :, None] + val[:, :, 1, None, :]
    cand_id = idx[:, :, 0, :, None] * PEER_N_KEYS + idx[:, :, 1, None, :]
    top_val, top_pos = lax.top_k(cand.reshape(n_tok, PEER_HEADS, PEER_TOPK * PEER_TOPK), PEER_TOPK)
    expert = jnp.take_along_axis(cand_id.reshape(n_tok, PEER_HEADS, PEER_TOPK * PEER_TOPK), top_pos, axis=-1)
    g = jax.nn.softmax(top_val, axis=-1)
    expert = expert.reshape(n_tok, PEER_HEADS * PEER_TOPK)
    act = jax.nn.gelu(hf @ u.T, approximate=False)
    a_sel = jnp.take_along_axis(act, expert, axis=-1)
    w = (g.reshape(n_tok, -1) * a_sel.astype(jnp.float32)).astype(act.dtype)
    gate = jnp.zeros_like(act).at[jnp.arange(n_tok)[:, None], expert].add(w)
    return (gate @ v).reshape(B, T, D)


def setup_inputs(seed: int = 0) -> dict:
    key = jax.random.key(seed)
    ks = jax.random.split(key, 21)
    L, D = DEPTH, D_MODEL

    def normal(k, shape, scale):
        return jax.random.normal(k, shape, jnp.float32) * scale

    def gain(k, shape):
        return 1.0 + 0.02 * jax.random.normal(k, shape, jnp.float32)

    return {
        'x': normal(ks[0], (BATCH, SEQ, D), 1.0),
        'mem': normal(ks[1], (BATCH, N_MEM, D), 1.0),
        'norm_mix_g': gain(ks[2], (L, D)),
        'w_in': normal(ks[3], (L, D, 3 * MIX_WIDTH), D ** -0.5),
        'moba_q_norm_g': gain(ks[4], (L, HEAD_DIM)),
        'moba_k_norm_g': gain(ks[5], (L, HEAD_DIM)),
        'moba_out_norm_g': gain(ks[6], (L, MOBA_WIDTH)),
        'sb_out_norm_g': gain(ks[7], (L, SB_WIDTH)),
        'w_out': normal(ks[8], (L, MIX_WIDTH, D), MIX_WIDTH ** -0.5),
        'norm_xattn_g': gain(ks[9], (L, D)),
        'norm_mem_g': gain(ks[10], (L, D)),
        'w_xq': normal(ks[11], (L, D, XATTN_WIDTH), D ** -0.5),
        'w_xkv': normal(ks[12], (L, D, 2 * XATTN_WIDTH), D ** -0.5),
        'xattn_q_norm_g': gain(ks[13], (L, HEAD_DIM)),
        'xattn_k_norm_g': gain(ks[14], (L, HEAD_DIM)),
        'w_xo': normal(ks[15], (L, XATTN_WIDTH, D), XATTN_WIDTH ** -0.5),
        'norm_ffn_g': gain(ks[16], (L, D)),
        'w_peer_q': normal(ks[17], (L, D, PEER_HEADS * PEER_KEY_DIM), D ** -0.5),
        'peer_sub_keys': normal(ks[18], (L, PEER_HEADS, 2, PEER_N_KEYS, PEER_HALF), PEER_HALF ** -0.5),
        'peer_u': normal(ks[19], (L, PEER_N_EXPERTS, D), D ** -0.5),
        'peer_v': normal(ks[20], (L, PEER_N_EXPERTS, D), PEER_HEADS ** -0.5),
    }


def reference(x, mem, norm_mix_g, w_in, moba_q_norm_g, moba_k_norm_g, moba_out_norm_g,
              sb_out_norm_g, w_out, norm_xattn_g, norm_mem_g, w_xq, w_xkv, xattn_q_norm_g,
              xattn_k_norm_g, w_xo, norm_ffn_g, w_peer_q, peer_sub_keys, peer_u, peer_v):
    slopes = alibi_slopes(N_MOBA_HEADS)
    splits = [MOBA_WIDTH, 2 * MOBA_WIDTH, 3 * MOBA_WIDTH,
              3 * MOBA_WIDTH + SB_WIDTH, 3 * MOBA_WIDTH + 2 * SB_WIDTH]
    for l in range(DEPTH):
        h = rmsnorm(x, norm_mix_g[l])
        proj = h @ w_in[l]
        mq, mk, mv, sq, sk, sv = jnp.split(proj, splits, axis=-1)
        mq = rmsnorm(split_heads(mq, N_MOBA_HEADS), moba_q_norm_g[l])
        mk = rmsnorm(split_heads(mk, N_MOBA_HEADS), moba_k_norm_g[l])
        o_moba = moba_attention(mq, mk, split_heads(mv, N_MOBA_HEADS), slopes)
        o_sb = stick_breaking_attention(split_heads(sq, N_SB_HEADS), split_heads(sk, N_SB_HEADS),
                                        split_heads(sv, N_SB_HEADS))
        o_moba = rmsnorm(merge_heads(o_moba), moba_out_norm_g[l])
        o_sb = rmsnorm(merge_heads(o_sb), sb_out_norm_g[l])
        x = x + jnp.concatenate([o_moba, o_sb], axis=-1) @ w_out[l]
        h = rmsnorm(x, norm_xattn_g[l])
        mem_n = rmsnorm(mem, norm_mem_g[l])
        x = x + cross_attention(h, mem_n, w_xq[l], w_xkv[l], xattn_q_norm_g[l],
                                xattn_k_norm_g[l], w_xo[l])
        h = rmsnorm(x, norm_ffn_g[l])
        x = x + peer_ffn(h, w_peer_q[l], peer_sub_keys[l], peer_u[l], peer_v[l])
    return x
```

```cpp
#include <hip/hip_runtime.h>
#include <cstdio>
#include <cstdint>
namespace pg8 {
#define PG8_LAS __attribute__((address_space(3)))
typedef unsigned short bf16_t;
typedef short bf16x8 __attribute__((ext_vector_type(8)));
typedef float f32x4 __attribute__((ext_vector_type(4)));
typedef unsigned u32x4 __attribute__((ext_vector_type(4)));
constexpr int BM = 256, BK = 64, HALF = 128, HTB = HALF * BK * 2  , STAGE_BYTES = 8 * HTB, NXCD = 8, WGM = 8;

__host__ __device__ __forceinline__ int lds_byte(int r, int c) { const int st = (r >> 4) * 2 + (c >> 5), rr = r & 15, cc = c & 31, ob = rr * 64 + cc * 2; return st * 1024 + (ob ^ (((ob >> 9) & 1) << 5)); }
__host__ __device__ __forceinline__ void stage_rc(int b, int& R, int& C) { const int st = b / 1024, sb = b % 1024, swz = sb ^ (((sb >> 9) & 1) << 5); R = (st >> 1) * 16 + swz / 64; C = (st & 1) * 32 + (swz % 64) / 2; }
__host__ __device__ __forceinline__ int perm32(int rho) { const int n = rho >> 4, i = rho & 15; return 8 * (i >> 2) + 4 * n + (i & 3); }

struct Unit { int pm, pn; };
struct Gemm { const bf16_t* A; const bf16_t* Bt; int M, N, K; };

struct StaticOrder {
    int nM, nN, nwg, G, c;
    __host__ __device__ void init(int M, int N, int G_, int c_) { nM = M / BM; nN = N / BM; nwg = nM * nN; G = G_; c = c_; }
    __host__ __device__ bool next(int i, Unit& u) const {
        const long L = (long)i * G + c; if (L >= nwg) return false;
        int wgid = (int)L; { const int q = nwg / NXCD, r = nwg % NXCD, xcd = wgid % NXCD, off = wgid / NXCD; wgid = (xcd < r ? xcd * (q + 1) : r * (q + 1) + (xcd - r) * q) + off; }
        const int nig = WGM * nN, gid = wgid / nig, fm = gid * WGM, gsz = (nM - fm) < WGM ? (nM - fm) : WGM;
        u.pm = fm + ((wgid % nig) % gsz); u.pn = (wgid % nig) / gsz; return true;
    }
    __device__ __forceinline__ void a_ready(const Unit&) const {}
    __device__ __forceinline__ void done(const Unit&) const {}
};

__device__ __forceinline__ unsigned cvt_pk_bf16(float lo, float hi) { unsigned r; asm volatile("v_cvt_pk_bf16_f32 %0, %1, %2" : "=v"(r) : "v"(lo), "v"(hi)); return r; }
typedef float f32x2 __attribute__((ext_vector_type(2)));
__device__ __forceinline__ f32x2 gelu_pk(f32x2 v) {
    const f32x2 av = __builtin_elementwise_abs(v), d = av * 0.2316418882f + 1.0f;
    f32x2 t; t.x = __builtin_amdgcn_rcpf(d.x); t.y = __builtin_amdgcn_rcpf(d.y);
    f32x2 q = t * 0.5307027145f + (-0.7265760135f); q = q * t + 0.7107068705f; q = q * t + (-0.142248368f); q = q * t + 0.127414796f; q = q * t;
    const f32x2 s = (v * v) * (-0.72134752044f);
    f32x2 e; e.x = __builtin_amdgcn_exp2f(s.x); e.y = __builtin_amdgcn_exp2f(s.y);
    const f32x2 m = v * (q * e), r = v - m;
    f32x2 o; o.x = v.x < 0.f ? m.x : r.x; o.y = v.y < 0.f ? m.y : r.y; return o;
}

template <int ACT  > struct EpiBf16 {
    static constexpr bool PERM = true, AFTER_DRAIN = false; static_assert(ACT == 0 || ACT == 1, "EpiBf16: ACT is 0 (none) or 1 (gelu_pk)");
    bf16_t* O; int ldc; const float* bias; int split_cols; size_t split_stride; float scale0;
    __device__ __forceinline__ void operator()(const f32x4 (&acc)[2][2][4][2], const Unit& u, int wr, int wc, int fr, int fq) const {
        const int row0 = u.pm * BM + wr * 64 + fr; int colt = u.pn * BM; bf16_t* base = O;
        float sc = 1.f; if (split_cols) { const int t = colt / split_cols; base += (size_t)t * split_stride; colt -= t * split_cols; if (t == 0) sc = scale0; }
        const int col0 = colt + wc * 32 + 8 * fq, bcol0 = u.pn * BM + wc * 32 + 8 * fq;
        f32x4 bv[2][2];
#pragma unroll
        for (int bj = 0; bj < 2; ++bj)
#pragma unroll
            for (int n = 0; n < 2; ++n) bv[bj][n] = bias ? *(const f32x4*)(bias + bcol0 + bj * HALF + 4 * n) : (f32x4){0.f, 0.f, 0.f, 0.f};
#pragma unroll
        for (int ai = 0; ai < 2; ++ai)
#pragma unroll
            for (int m = 0; m < 4; ++m) { bf16_t* rowp = base + (size_t)(row0 + ai * HALF + m * 16) * ldc + col0;
#pragma unroll
                for (int bj = 0; bj < 2; ++bj) { f32x4 v0 = acc[ai][bj][m][0] + bv[bj][0], v1 = acc[ai][bj][m][1] + bv[bj][1];
                    if (ACT == 1) { f32x2 a = gelu_pk((f32x2){v0[0], v0[1]}), b = gelu_pk((f32x2){v0[2], v0[3]}), c = gelu_pk((f32x2){v1[0], v1[1]}), d = gelu_pk((f32x2){v1[2], v1[3]});
                        v0 = (f32x4){a.x, a.y, b.x, b.y}; v1 = (f32x4){c.x, c.y, d.x, d.y}; }
                    v0 = v0 * sc; v1 = v1 * sc; u32x4 w; w.x = cvt_pk_bf16(v0[0], v0[1]); w.y = cvt_pk_bf16(v0[2], v0[3]); w.z = cvt_pk_bf16(v1[0], v1[1]); w.w = cvt_pk_bf16(v1[2], v1[3]);
                    *(u32x4*)(rowp + bj * HALF) = w; } }
    }
};

template <class Epi, class Sched, bool ALIGN_EPI = false, bool SP2 = false>
__device__ __forceinline__ void gemm_phase(PG8_LAS unsigned char* lds, const Gemm g, const Sched& S, const Epi& E) {
    const int tid = threadIdx.x, wid = __builtin_amdgcn_readfirstlane(tid >> 6), lane = tid & 63, wr = wid >> 2, wc = wid & 3, fr = lane & 15, fq = lane >> 4;
    const int K = g.K, nt = K / BK;
    unsigned voffA[2], voffB[2];
#pragma unroll
    for (int i = 0; i < 2; ++i) { int R, C; stage_rc(tid * 16 + i * 8192, R, C); const int Rb = Epi::PERM ? ((R & ~31) + perm32(R & 31)) : R;
        voffA[i] = (unsigned)(R * K + C) * 2u; voffB[i] = (unsigned)(Rb * K + C) * 2u; }
    const size_t kstep = (size_t)(BK * 2);
    const size_t hstep = (size_t)HALF * K * 2;
    const size_t tstep = 2 * hstep;
    const unsigned ldsw = (unsigned)wid * 1024u;
    const int aoff = lds_byte(wr * 64 + fr, fq * 8), boff = lds_byte(wc * 32 + fr, fq * 8);
#define PG8_SA(b, h) (((b) * 2 + (h)) * HTB)
#define PG8_SB(b, h) ((4 + (b) * 2 + (h)) * HTB)
#define PG8_STAGE(bufoff, gbase, voff) do { _Pragma("unroll") for (int _i = 0; _i < 2; ++_i) \
        __builtin_amdgcn_global_load_lds((const unsigned*)((const char*)(gbase) + (voff)[_i]), (PG8_LAS unsigned*)(lds + (bufoff) + ldsw + _i * 8192), 16, 0, 0); } while (0)
#define PG8_LDA(dst, b, h) do { _Pragma("unroll") for (int m = 0; m < 4; ++m) _Pragma("unroll") for (int k = 0; k < 2; ++k) dst[m][k] = *(const PG8_LAS bf16x8*)(lds + PG8_SA(b, h) + aoff + m * 2048 + k * 1024); } while (0)
#define PG8_LDB(dst, b, h) do { _Pragma("unroll") for (int n = 0; n < 2; ++n) _Pragma("unroll") for (int k = 0; k < 2; ++k) dst[n][k] = *(const PG8_LAS bf16x8*)(lds + PG8_SB(b, h) + boff + n * 2048 + k * 1024); } while (0)
#define PG8_MMA(ai, bj, At, Bt) do { __builtin_amdgcn_s_setprio(1); _Pragma("unroll") for (int m = 0; m < 4; ++m) _Pragma("unroll") for (int n = 0; n < 2; ++n) _Pragma("unroll") for (int k = 0; k < 2; ++k) \
        acc[ai][bj][m][n] = __builtin_amdgcn_mfma_f32_16x16x32_bf16(Bt[n][k], At[m][k], acc[ai][bj][m][n], 0, 0, 0); __builtin_amdgcn_s_setprio(0); } while (0)
#define PG8_WAIT_V(n) asm volatile("s_waitcnt vmcnt(" #n ")" ::: "memory")
#define PG8_WAIT_L(n) asm volatile("s_waitcnt lgkmcnt(" #n ")" ::: "memory")
#define PG8_BAR __builtin_amdgcn_s_barrier()
#define PG8_SCHED __builtin_amdgcn_sched_barrier(0)
    Unit cur, nxt; int ui = 0;
    if (!S.next(0, cur)) return;
    f32x4 acc[2][2][4][2];
#pragma unroll
    for (int a = 0; a < 2; ++a)
#pragma unroll
        for (int b = 0; b < 2; ++b)
#pragma unroll
            for (int m = 0; m < 4; ++m)
#pragma unroll
                for (int n = 0; n < 2; ++n) acc[a][b][m][n] = (f32x4){0.f, 0.f, 0.f, 0.f};
    bf16x8 At[4][2], B0[2][2], B1[2][2];
    const char* cA = (const char*)g.A + (size_t)cur.pm * tstep; const char* cB = (const char*)g.Bt + (size_t)cur.pn * tstep;
    S.a_ready(cur);
    if constexpr (SP2) {
        PG8_STAGE(PG8_SB(0, 0), cB, voffB); PG8_STAGE(PG8_SB(0, 1), cB + hstep, voffB); PG8_STAGE(PG8_SA(0, 0), cA, voffA); PG8_STAGE(PG8_SA(0, 1), cA + hstep, voffA);
        if (wr == 1) PG8_BAR;
        PG8_WAIT_V(2); PG8_BAR;
        PG8_STAGE(PG8_SB(1, 0), cB + kstep, voffB); PG8_STAGE(PG8_SA(1, 0), cA + kstep, voffA); PG8_STAGE(PG8_SB(1, 1), cB + hstep + kstep, voffB);
        PG8_WAIT_V(6); PG8_BAR;
    } else {
        PG8_STAGE(PG8_SB(0, 0), cB, voffB); PG8_STAGE(PG8_SA(0, 0), cA, voffA); PG8_STAGE(PG8_SB(0, 1), cB + hstep, voffB); PG8_STAGE(PG8_SA(0, 1), cA + hstep, voffA);
        if (wr == 1) PG8_BAR;
        PG8_WAIT_V(4); PG8_BAR;
        PG8_STAGE(PG8_SB(1, 0), cB + kstep, voffB); PG8_STAGE(PG8_SA(1, 0), cA + kstep, voffA); PG8_STAGE(PG8_SB(1, 1), cB + hstep + kstep, voffB);
        PG8_WAIT_V(6); PG8_BAR;
    }
    for (;;) {
        const bool has_next = S.next(ui + 1, nxt);
        const char* nA = has_next ? (const char*)g.A + (size_t)nxt.pm * tstep : cA; const char* nB = has_next ? (const char*)g.Bt + (size_t)nxt.pn * tstep : cB;
        for (int t = 0; t < nt; t += 2) {
            const bool last = (t == nt - 2);
            const char* a1 = cA + (size_t)(t + 1) * kstep;
            const char* a2 = last ? nA : cA + (size_t)(t + 2) * kstep; const char* b2 = last ? nB : cB + (size_t)(t + 2) * kstep;
            const char* a3 = a2 + kstep; const char* b3 = b2 + kstep;
            if (last && has_next) S.a_ready(nxt);
            if constexpr (SP2) {
            PG8_LDB(B0, 0, 0); PG8_LDB(B1, 0, 1); PG8_SCHED; PG8_LDA(At, 0, 0); PG8_STAGE(PG8_SA(1, 1), a1 + hstep, voffA);
            PG8_WAIT_V(8); PG8_WAIT_L(0); PG8_BAR; PG8_MMA(0, 0, At, B0); PG8_MMA(0, 1, At, B1); PG8_BAR; PG8_SCHED;
            PG8_LDA(At, 0, 1); PG8_STAGE(PG8_SB(0, 0), b2, voffB); PG8_STAGE(PG8_SB(0, 1), b2 + hstep, voffB); PG8_STAGE(PG8_SA(0, 0), a2, voffA);
            PG8_WAIT_V(8); PG8_WAIT_L(0); PG8_BAR; PG8_MMA(1, 0, At, B0); PG8_MMA(1, 1, At, B1); PG8_BAR; PG8_SCHED;
            PG8_LDB(B0, 1, 0); PG8_LDB(B1, 1, 1); PG8_SCHED; PG8_LDA(At, 1, 0); PG8_STAGE(PG8_SA(0, 1), a2 + hstep, voffA);
            PG8_WAIT_V(8); PG8_WAIT_L(0); PG8_BAR; PG8_MMA(0, 0, At, B0); PG8_MMA(0, 1, At, B1); PG8_BAR; PG8_SCHED;
            PG8_LDA(At, 1, 1); PG8_STAGE(PG8_SB(1, 0), b3, voffB); PG8_STAGE(PG8_SB(1, 1), b3 + hstep, voffB); PG8_STAGE(PG8_SA(1, 0), a3, voffA);
            PG8_WAIT_V(8); PG8_WAIT_L(0); PG8_BAR; PG8_MMA(1, 0, At, B0); PG8_MMA(1, 1, At, B1); PG8_BAR; PG8_SCHED;
            } else {
            PG8_LDB(B0, 0, 0); PG8_SCHED; PG8_LDA(At, 0, 0); PG8_STAGE(PG8_SA(1, 1), a1 + hstep, voffA);
            PG8_WAIT_L(8); PG8_BAR; PG8_WAIT_L(0); PG8_MMA(0, 0, At, B0); PG8_BAR; PG8_SCHED;
            PG8_LDB(B1, 0, 1); PG8_STAGE(PG8_SB(0, 0), b2, voffB);
            PG8_BAR; PG8_WAIT_L(0); PG8_MMA(0, 1, At, B1); PG8_BAR;
            PG8_LDA(At, 0, 1); PG8_STAGE(PG8_SA(0, 0), a2, voffA);
            PG8_BAR; PG8_WAIT_L(0); PG8_MMA(1, 0, At, B0); PG8_BAR; PG8_SCHED;
            PG8_STAGE(PG8_SB(0, 1), b2 + hstep, voffB);
            PG8_WAIT_V(6); PG8_BAR; PG8_MMA(1, 1, At, B1); PG8_BAR;
            PG8_LDB(B0, 1, 0); PG8_SCHED; PG8_LDA(At, 1, 0); PG8_STAGE(PG8_SA(0, 1), a2 + hstep, voffA);
            PG8_WAIT_L(8); PG8_BAR; PG8_WAIT_L(0); PG8_MMA(0, 0, At, B0); PG8_BAR; PG8_SCHED;
            PG8_LDB(B1, 1, 1); PG8_STAGE(PG8_SB(1, 0), b3, voffB);
            PG8_BAR; PG8_WAIT_L(0); PG8_MMA(0, 1, At, B1); PG8_BAR;
            PG8_LDA(At, 1, 1); PG8_STAGE(PG8_SA(1, 0), a3, voffA);
            PG8_BAR; PG8_WAIT_L(0); PG8_MMA(1, 0, At, B0); PG8_BAR; PG8_SCHED;
            PG8_STAGE(PG8_SB(1, 1), b3 + hstep, voffB);
            PG8_WAIT_V(6); PG8_BAR; PG8_MMA(1, 1, At, B1); PG8_BAR;
            }
        }
        if constexpr (ALIGN_EPI) { if (wr == 0) PG8_BAR; }
        if constexpr (!Epi::AFTER_DRAIN) { E(acc, cur, wr, wc, fr, fq); S.done(cur); }
        if (!has_next) break;
#pragma unroll
        for (int a = 0; a < 2; ++a)
#pragma unroll
            for (int b = 0; b < 2; ++b)
#pragma unroll
                for (int m = 0; m < 4; ++m)
#pragma unroll
                    for (int n = 0; n < 2; ++n) acc[a][b][m][n] = (f32x4){0.f, 0.f, 0.f, 0.f};
        cur = nxt; cA = nA; cB = nB; ++ui;
        if constexpr (ALIGN_EPI) { if (wr == 1) PG8_BAR; }
    }
    PG8_WAIT_V(0);
    if constexpr (!ALIGN_EPI) { if (wr == 0) PG8_BAR; }
    PG8_BAR;
    if constexpr (Epi::AFTER_DRAIN) { E.fused(acc, cur, wr, wc, fr, fq, lds, wid, lane); S.done(cur); }
#undef PG8_SA
#undef PG8_SB
#undef PG8_STAGE
#undef PG8_LDA
#undef PG8_LDB
#undef PG8_MMA
#undef PG8_WAIT_V
#undef PG8_WAIT_L
#undef PG8_BAR
#undef PG8_SCHED
}
}

namespace pg8 {
struct EpiF32Res {
    static constexpr bool PERM = false, AFTER_DRAIN = false;
    const float* base; float* out; int ldc;
    __device__ __forceinline__ void operator()(const f32x4 (&acc)[2][2][4][2], const Unit& u, int wr, int wc, int fr, int fq) const {
        const int row0 = u.pm * BM + wr * 64 + fr, col0 = u.pn * BM + wc * 32 + 4 * fq;
#pragma unroll
        for (int ai = 0; ai < 2; ++ai)
#pragma unroll
            for (int m = 0; m < 4; ++m) { const size_t off = (size_t)(row0 + ai * HALF + m * 16) * ldc + col0;
#pragma unroll
                for (int bj = 0; bj < 2; ++bj)
#pragma unroll
                    for (int n = 0; n < 2; ++n) { const f32x4 bs = *(const f32x4*)(base + off + bj * HALF + n * 16); *(f32x4*)(out + off + bj * HALF + n * 16) = bs + acc[ai][bj][m][n]; } }
    }
};
struct EpiGate {
    static constexpr bool PERM = true, AFTER_DRAIN = false;
    bf16_t* G; int ldc;
    __device__ __forceinline__ void operator()(const f32x4 (&acc)[2][2][4][2], const Unit& u, int wr, int wc, int fr, int fq) const {
        const int row0 = u.pm * BM + wr * 64 + fr, col0 = u.pn * BM + wc * 32 + 8 * fq;
#pragma unroll
        for (int ai = 0; ai < 2; ++ai)
#pragma unroll
            for (int m = 0; m < 4; ++m) { bf16_t* rowp = G + (size_t)(row0 + ai * HALF + m * 16) * ldc + col0;
#pragma unroll
                for (int bj = 0; bj < 2; ++bj) { const u32x4 g = *(const u32x4*)(rowp + bj * HALF);
                    if ((g.x | g.y | g.z | g.w) != 0u) {
                        const f32x4 v0 = acc[ai][bj][m][0], v1 = acc[ai][bj][m][1];
                        const f32x2 a = gelu_pk((f32x2){v0[0], v0[1]}), b = gelu_pk((f32x2){v0[2], v0[3]}), c = gelu_pk((f32x2){v1[0], v1[1]}), d = gelu_pk((f32x2){v1[2], v1[3]});
                        u32x4 w;
                        w.x = cvt_pk_bf16(a.x * __uint_as_float(g.x << 16), a.y * __uint_as_float(g.x & 0xffff0000u));
                        w.y = cvt_pk_bf16(b.x * __uint_as_float(g.y << 16), b.y * __uint_as_float(g.y & 0xffff0000u));
                        w.z = cvt_pk_bf16(c.x * __uint_as_float(g.z << 16), c.y * __uint_as_float(g.z & 0xffff0000u));
                        w.w = cvt_pk_bf16(d.x * __uint_as_float(g.w << 16), d.y * __uint_as_float(g.w & 0xffff0000u));
                        *(u32x4*)(rowp + bj * HALF) = w; } } }
    }
};
}

constexpr int NB = 4, T = 4096, D = 4096, M = NB * T;
constexpr int NPROJ = 12288;
constexpr int NMEM = 256, XW = 512, PQW = 2048, NEXP = 16384;
constexpr float RMS_EPS = 1e-6f;
constexpr int NWAVES = 8;

constexpr size_t MiB = 1u << 20;
constexpr size_t WS_CTL = 0, CTL_ZERO_BYTES = 1 * MiB;
constexpr size_t WS_KMEAN = 1 * MiB;
constexpr size_t WS_SUBK = 2 * MiB;
constexpr size_t WS_MEMN = 4 * MiB;
constexpr size_t WS_KVMEM = 12 * MiB;
constexpr size_t WS_WXQ = 16 * MiB;
constexpr size_t WS_WXKV = 20 * MiB;
constexpr size_t WS_WXO = 28 * MiB;
constexpr size_t WS_WPQ = 32 * MiB;
constexpr size_t WS_WOUT = 48 * MiB;
constexpr size_t WS_WIN = 80 * MiB;
constexpr size_t WS_PQ = 80 * MiB;
constexpr size_t WS_XQ = 144 * MiB;
constexpr size_t WS_XO = 160 * MiB;
constexpr size_t WS_U = 176 * MiB;
constexpr size_t WS_VT = 304 * MiB;
constexpr size_t WS_H = 432 * MiB;
constexpr size_t WS_PROJ = 560 * MiB;
constexpr size_t WS_AO = 944 * MiB;
constexpr size_t WS_GATE = 560 * MiB;
constexpr size_t WS_END = 1072 * MiB;
constexpr int CW_BAR = 4096;

constexpr int RING_BYTES = 131072;
constexpr int MISC_OFF = RING_BYTES + 320;
constexpr int LDS_BYTES = 147456;

#define GAS __attribute__((address_space(1)))
#define LAS __attribute__((address_space(3)))
typedef unsigned short bf16;
typedef unsigned v4u __attribute__((ext_vector_type(4)));
typedef float f32x4 __attribute__((ext_vector_type(4)));
typedef short bf16x8 __attribute__((ext_vector_type(8)));
typedef GAS unsigned gu32;
typedef GAS unsigned long long gu64;
#define RLX_AGENT __ATOMIC_RELAXED, __HIP_MEMORY_SCOPE_AGENT
#define LDS_WAIT() asm volatile("s_waitcnt lgkmcnt(0)" ::: "memory")
#define VM_WAIT() asm volatile("s_waitcnt vmcnt(0)" ::: "memory")
__device__ __forceinline__ unsigned long long rt() { return __builtin_amdgcn_s_memrealtime(); }
__device__ __forceinline__ unsigned f2bf(float f) { unsigned u = __builtin_bit_cast(unsigned, f); return (u + 0x7fffu + ((u >> 16) & 1u)) >> 16; }
__device__ __forceinline__ unsigned pk2(float lo, float hi) { return f2bf(lo) | (f2bf(hi) << 16); }

#define XB_TMO      128
#define XB_XCNT(j)  (256  + 64 * (j))
#define XB_XSUB(j)  (1280 + 64 * (j))
#define XB_XGEN(j)  (2304 + 64 * (j))
#define XB_TOP      3328
#define XB_TOPGEN   3392
#define XCD_BAR_WORDS 3456
#define XB_SPIN_CAP (1u << 18)

__device__ __forceinline__ unsigned xb_ld(unsigned* p)              { return __hip_atomic_load(p, __ATOMIC_RELAXED, __HIP_MEMORY_SCOPE_AGENT); }
__device__ __forceinline__ unsigned xb_add(unsigned* p, unsigned v) { return __hip_atomic_fetch_add(p, v, __ATOMIC_RELAXED, __HIP_MEMORY_SCOPE_AGENT); }
__device__ __forceinline__ unsigned xb_xcc_id() { return (unsigned)__builtin_amdgcn_s_getreg((3 << 11) | 20) & 0xFu; }
#define XB_SPIN(cond, bar) do { unsigned _sp = 0; while (cond) { __builtin_amdgcn_s_sleep(1); \
    if ((++_sp & 255u) == 0u) { if (xb_ld(&(bar)[XB_TMO])) break; if (_sp > XB_SPIN_CAP) { atomicAdd(&(bar)[XB_TMO], 1u); break; } } } } while (0)

struct XcdBarrier {
    unsigned* bar; unsigned x;
    volatile LAS unsigned* st;
};

__device__ __forceinline__ XcdBarrier xcd_barrier_post(unsigned* bar, volatile LAS unsigned* st) {
    XcdBarrier b; b.bar = bar; b.x = xb_xcc_id(); b.st = st;
    if (threadIdx.x == 0) (void)xb_add(&bar[XB_XCNT(b.x)], 1u);
    return b;
}
__device__ __forceinline__ void xcd_barrier_complete(unsigned* bar, unsigned x, unsigned& nloc, unsigned& nx) {
    const unsigned G = gridDim.x * gridDim.y * gridDim.z;
    unsigned sum, cnt, mine, sp = 0u;
    for (;;) {
        sum = 0u; cnt = 0u; mine = 0u;
#pragma unroll
        for (unsigned j = 0; j < 16; ++j) { const unsigned c = xb_ld(&bar[XB_XCNT(j)]); sum += c; cnt += (c > 0u) ? 1u : 0u; mine = (j == x) ? c : mine; }
        if (sum == G) break;
        __builtin_amdgcn_s_sleep(1);
        if ((++sp & 255u) == 0u) { if (xb_ld(&bar[XB_TMO])) break; if (sp > XB_SPIN_CAP) { atomicAdd(&bar[XB_TMO], 1u); break; } }
    }
    nloc = mine > 0u ? mine : 1u; nx = cnt > 0u ? cnt : 1u;
}

__device__ __forceinline__ void xcd_barrier(const XcdBarrier& b) {
    asm volatile("s_waitcnt vmcnt(0)" ::: "memory");
    __syncthreads();
    if (threadIdx.x == 0) {
        unsigned* bar = b.bar;
        __builtin_amdgcn_s_waitcnt(0);
        unsigned nloc = b.st[0], nx = b.st[1];
        if (nloc == 0u) { xcd_barrier_complete(bar, b.x, nloc, nx); b.st[0] = nloc; b.st[1] = nx; }
        const unsigned old = xb_add(&bar[XB_XSUB(b.x)], 1u);
        const unsigned gen = old / nloc;
        if (old + 1u == (gen + 1u) * nloc) {
            __builtin_amdgcn_fence(__ATOMIC_RELEASE, "agent");
            asm volatile("s_waitcnt vmcnt(0)" ::: "memory");
            const unsigned og = xb_add(&bar[XB_TOP], 1u);
            const unsigned tg = og / nx;
            if (og + 1u == (tg + 1u) * nx) xb_add(&bar[XB_TOPGEN], 1u);
            else XB_SPIN(xb_ld(&bar[XB_TOPGEN]) == tg, bar);
            __builtin_amdgcn_fence(__ATOMIC_ACQUIRE, "agent");
            xb_add(&bar[XB_XGEN(b.x)], 1u);
            asm volatile("s_waitcnt vmcnt(0)" ::: "memory");
        } else {
            XB_SPIN(xb_ld(&bar[XB_XGEN(b.x)]) == gen, bar);
            __builtin_amdgcn_fence(__ATOMIC_ACQUIRE, "agent");
            asm volatile("s_waitcnt vmcnt(0)" ::: "memory");
        }
    }
    __syncthreads();
}
typedef unsigned v2u __attribute__((ext_vector_type(2)));
typedef float f32x16 __attribute__((ext_vector_type(16)));
typedef short s16x4 __attribute__((ext_vector_type(4)));
typedef short v2s __attribute__((ext_vector_type(2)));
#define SBAR() __builtin_amdgcn_sched_barrier(0)

__device__ __forceinline__ float bflo(unsigned w) { return __uint_as_float(w << 16); }
__device__ __forceinline__ float bfhi(unsigned w) { return __uint_as_float(w & 0xffff0000u); }
__device__ __forceinline__ float wave_sum(float v) {
#pragma unroll
    for (int o = 1; o < 64; o <<= 1) v += __shfl_xor(v, o);
    return v;
}
__device__ __forceinline__ void pair_get(unsigned x, unsigned& v0, unsigned& v1) { auto rr = __builtin_amdgcn_permlane32_swap(x, x, false, false); v0 = rr[0]; v1 = rr[1]; }
__device__ __forceinline__ float pair_max(float x) { unsigned a, b; pair_get(__float_as_uint(x), a, b); return fmaxf(__uint_as_float(a), __uint_as_float(b)); }
__device__ __forceinline__ float pair_sum(float x) { unsigned a, b; pair_get(__float_as_uint(x), a, b); return __uint_as_float(a) + __uint_as_float(b); }
__device__ __forceinline__ int pair_sumi(int x) { unsigned a, b; pair_get((unsigned)x, a, b); return (int)(a + b); }
__device__ __forceinline__ float pair_other(float x, int hi) { unsigned a, b; pair_get(__float_as_uint(x), a, b); return __uint_as_float(hi ? a : b); }


__device__ __forceinline__ void p0_transpose_item(const float* W, int K, int N, bf16* WT, LAS float* scr, int item, int lane) {
    const int nblk = N / 32, kb = item / nblk, nb = item % nblk, k0 = 64 * kb, n0 = 32 * nb;
#pragma unroll 8
    for (int i = 0; i < 32; ++i) { const int kk = 2 * i + (lane >> 5); scr[kk * 33 + (lane & 31)] = W[(size_t)(k0 + kk) * N + n0 + (lane & 31)]; }
    LDS_WAIT(); asm volatile("" ::: "memory");
    const int c = lane & 7;
#pragma unroll
    for (int j = 0; j < 4; ++j) { const int n = (lane >> 3) + 8 * j; const LAS float* s = scr + (8 * c) * 33 + n;
        v4u o; o.x = pk2(s[0 * 33], s[1 * 33]); o.y = pk2(s[2 * 33], s[3 * 33]); o.z = pk2(s[4 * 33], s[5 * 33]); o.w = pk2(s[6 * 33], s[7 * 33]);
        *(GAS v4u*)(WT + (size_t)(n0 + n) * K + k0 + 8 * c) = o; }
    LDS_WAIT(); asm volatile("" ::: "memory");
}
__device__ __forceinline__ void rms_row_4096(const float* xrow, const float* g, bf16* orow, int lane) {
    const GAS f32x4* xr = (const GAS f32x4*)xrow + lane;
    f32x4 v[16]; float s = 0.f;
#pragma unroll
    for (int j = 0; j < 16; ++j) { v[j] = xr[64 * j]; s += (v[j].x * v[j].x + v[j].y * v[j].y) + (v[j].z * v[j].z + v[j].w * v[j].w); }
    const float r = 1.0f / sqrtf(wave_sum(s) * (1.f / 4096.f) + RMS_EPS);
    const GAS f32x4* gr = (const GAS f32x4*)g + lane;
    GAS v2u* o8 = (GAS v2u*)orow + lane;
#pragma unroll
    for (int j = 0; j < 16; ++j) { const f32x4 gg = gr[64 * j]; v2u w; w.x = pk2(v[j].x * r * gg.x, v[j].y * r * gg.y); w.y = pk2(v[j].z * r * gg.z, v[j].w * r * gg.w); o8[64 * j] = w; }
}
__device__ __forceinline__ void cvt_f32_bf16(const float* src, bf16* dst, size_t n, size_t gtid, size_t gthreads) {
    for (size_t i = gtid * 8; i < n; i += gthreads * 8) { const f32x4 a = *(const GAS f32x4*)(src + i), b = *(const GAS f32x4*)(src + i + 4);
        v4u o; o.x = pk2(a.x, a.y); o.y = pk2(a.z, a.w); o.z = pk2(b.x, b.y); o.w = pk2(b.z, b.w); *(GAS v4u*)(dst + i) = o; }
}

__device__ __forceinline__ void qknorm_unit(bf16* PROJ, int row0, int col0, const float* g, bf16* km, LAS float* scr, int tid) {
    const int rr = tid >> 4, ch = tid & 15, wid = tid >> 6, lane = tid & 63;
    float gg[8];
#pragma unroll
    for (int j = 0; j < 8; ++j) gg[j] = g[ch * 8 + j];
    float cs[8] = {0.f, 0.f, 0.f, 0.f, 0.f, 0.f, 0.f, 0.f};
#pragma unroll 2
    for (int p = 0; p < 8; ++p) {
        bf16* ptr = PROJ + (size_t)(row0 + p * 32 + rr) * NPROJ + col0 + ch * 8;
        const v4u w = *(const GAS v4u*)ptr;
        float x[8] = {bflo(w.x), bfhi(w.x), bflo(w.y), bfhi(w.y), bflo(w.z), bfhi(w.z), bflo(w.w), bfhi(w.w)};
        float ss = 0.f;
#pragma unroll
        for (int j = 0; j < 8; ++j) ss += x[j] * x[j];
        ss += __shfl_xor(ss, 1); ss += __shfl_xor(ss, 2); ss += __shfl_xor(ss, 4); ss += __shfl_xor(ss, 8);
        const float r = 1.0f / sqrtf(ss * (1.f / 128.f) + RMS_EPS);
#pragma unroll
        for (int j = 0; j < 8; ++j) { x[j] = x[j] * r * gg[j]; cs[j] += x[j]; }
        v4u o; o.x = pk2(x[0], x[1]); o.y = pk2(x[2], x[3]); o.z = pk2(x[4], x[5]); o.w = pk2(x[6], x[7]);
        *(GAS v4u*)ptr = o;
    }
    if (km) {
#pragma unroll
        for (int j = 0; j < 8; ++j) { cs[j] += __shfl_xor(cs[j], 16); cs[j] += __shfl_xor(cs[j], 32); }
        if (lane < 16) {
#pragma unroll
            for (int j = 0; j < 8; ++j) scr[wid * 128 + ch * 8 + j] = cs[j]; }
        __syncthreads();
        if (tid < 128) { float s = 0.f;
#pragma unroll
            for (int w = 0; w < 8; ++w) s += scr[w * 128 + tid];
            km[tid] = (bf16)f2bf(s * (1.f / 256.f)); }
        __syncthreads();
    }
}

__device__ __forceinline__ void outnorm_row(bf16* row, const float* gm, const float* gs, int lane) {
    v4u w[8]; float s0 = 0.f, s1 = 0.f;
#pragma unroll
    for (int j = 0; j < 8; ++j) { w[j] = *(const GAS v4u*)(row + (size_t)(lane + 64 * j) * 8);
        const float x[8] = {bflo(w[j].x), bfhi(w[j].x), bflo(w[j].y), bfhi(w[j].y), bflo(w[j].z), bfhi(w[j].z), bflo(w[j].w), bfhi(w[j].w)};
        float ss = 0.f;
#pragma unroll
        for (int k = 0; k < 8; ++k) ss += x[k] * x[k];
        if (j < 4) s0 += ss; else s1 += ss; }
    const float r0 = 1.0f / sqrtf(wave_sum(s0) * (1.f / 2048.f) + RMS_EPS), r1 = 1.0f / sqrtf(wave_sum(s1) * (1.f / 2048.f) + RMS_EPS);
#pragma unroll
    for (int j = 0; j < 8; ++j) { const int c = (lane + 64 * j) * 8; const float* g = (j < 4) ? (gm + c) : (gs + c - 2048); const float r = (j < 4) ? r0 : r1;
        const f32x4 ga = *(const GAS f32x4*)g, gb = *(const GAS f32x4*)(g + 4);
        v4u o; o.x = pk2(bflo(w[j].x) * r * ga.x, bfhi(w[j].x) * r * ga.y); o.y = pk2(bflo(w[j].y) * r * ga.z, bfhi(w[j].y) * r * ga.w);
        o.z = pk2(bflo(w[j].z) * r * gb.x, bfhi(w[j].z) * r * gb.y); o.w = pk2(bflo(w[j].w) * r * gb.z, bfhi(w[j].w) * r * gb.w);
        *(GAS v4u*)(row + c) = o; }
}

#define KSWZ(row, colB) ((row) * 256 + ((colB) ^ (((row) & 7) << 4)))
constexpr int ATT_TILE = 16384;
__device__ __forceinline__ int v_st(int k, int c) { const int kk = (k & ~0xC) | ((k & 4) << 1) | ((k & 8) >> 1); return ((kk >> 3) * 4 + (c >> 5)) * 512 + ((kk & 7) * 32 + (c & 31)) * 2; }
__device__ __forceinline__ int v_rd_base(int lane) { return ((lane & 3) << 3) | (((lane >> 2) & 3) << 6) | (((lane >> 4) & 1) << 5) | (((lane >> 5) & 1) << 8); }
constexpr int v_rd_off(int d0, int ks, int half) { return d0 * 512 + ks * 4096 + half * 2048; }
__device__ __forceinline__ int crow(int r, int hi) { return (r & 3) + 8 * (r >> 2) + 4 * hi; }
__device__ __forceinline__ unsigned cvtpk(float lo, float hi) { unsigned r; asm volatile("v_cvt_pk_bf16_f32 %0, %1, %2" : "=v"(r) : "v"(lo), "v"(hi)); return r; }

__device__ __forceinline__ void qkt64(f32x16& p0, f32x16& p1, const LAS char* Kt, int r32, int hi, const bf16x8* qr) {
    p0 = f32x16{}; p1 = f32x16{};
    const LAS char* kb[4];
#pragma unroll
    for (int dd = 0; dd < 4; ++dd) kb[dd] = Kt + KSWZ(r32, (dd * 16 + hi * 8) * 2);
#pragma unroll
    for (int d0 = 0; d0 < 8; ++d0) { const LAS char* a = kb[d0 & 3] + (d0 >> 2) * 128;
        const bf16x8 b0 = *(const LAS bf16x8*)a;
        const bf16x8 b1 = *(const LAS bf16x8*)(a + 32 * 256);
        p0 = __builtin_amdgcn_mfma_f32_32x32x16_bf16(b0, qr[d0], p0, 0, 0, 0);
        p1 = __builtin_amdgcn_mfma_f32_32x32x16_bf16(b1, qr[d0], p1, 0, 0, 0); }
}
__device__ __forceinline__ void qkt32(f32x16& p0, const LAS char* Kt, int r32, int hi, const bf16x8* qr) {
    p0 = f32x16{};
#pragma unroll
    for (int d0 = 0; d0 < 8; ++d0) { const bf16x8 b0 = *(const LAS bf16x8*)(Kt + KSWZ(r32, (d0 * 16 + hi * 8) * 2));
        p0 = __builtin_amdgcn_mfma_f32_32x32x16_bf16(b0, qr[d0], p0, 0, 0, 0); }
}
__device__ __forceinline__ void pack_p(const f32x16& p0, const f32x16& p1, bf16x8& pa0, bf16x8& pa1, bf16x8& pa2, bf16x8& pa3) {
#define PK4(P, B_, OUT) do { unsigned a0 = cvtpk(P[B_+0], P[B_+1]), a1 = cvtpk(P[B_+2], P[B_+3]);                          \
        unsigned b0 = cvtpk(P[B_+4], P[B_+5]), b1 = cvtpk(P[B_+6], P[B_+7]);                                             \
        auto r0 = __builtin_amdgcn_permlane32_swap(a0, b0, false, false); auto r1 = __builtin_amdgcn_permlane32_swap(a1, b1, false, false); \
        v4u w = {r0[0], r1[0], r0[1], r1[1]}; OUT = __builtin_bit_cast(bf16x8, w); } while (0)
    PK4(p0, 0, pa0); PK4(p0, 8, pa1); PK4(p1, 0, pa2); PK4(p1, 8, pa3);
#undef PK4
}
__device__ __forceinline__ void pv64(f32x16* o, int vb0, bf16x8 pa0, bf16x8 pa1, bf16x8 pa2, bf16x8 pa3) {
#define TRRD(dst, off) asm volatile("ds_read_b64_tr_b16 %0, %1 offset:%2" : "=&v"(dst) : "v"(vb0), "i"(off) : "memory")
#define PV_D0(d0) do { s16x4 l0, l1, l2, l3, h0, h1, h2, h3; constexpr int b_ = v_rd_off(d0, 0, 0); \
        TRRD(l0, b_); TRRD(h0, b_ + 2048); TRRD(l1, b_ + 4096); TRRD(h1, b_ + 6144); TRRD(l2, b_ + 8192); TRRD(h2, b_ + 10240); TRRD(l3, b_ + 12288); TRRD(h3, b_ + 14336); \
        asm volatile("s_waitcnt lgkmcnt(0)" ::: "memory"); SBAR();   \
        o[d0] = __builtin_amdgcn_mfma_f32_32x32x16_bf16(pa0, (bf16x8){l0[0], l0[1], l0[2], l0[3], h0[0], h0[1], h0[2], h0[3]}, o[d0], 0, 0, 0);   \
        o[d0] = __builtin_amdgcn_mfma_f32_32x32x16_bf16(pa1, (bf16x8){l1[0], l1[1], l1[2], l1[3], h1[0], h1[1], h1[2], h1[3]}, o[d0], 0, 0, 0);   \
        o[d0] = __builtin_amdgcn_mfma_f32_32x32x16_bf16(pa2, (bf16x8){l2[0], l2[1], l2[2], l2[3], h2[0], h2[1], h2[2], h2[3]}, o[d0], 0, 0, 0);   \
        o[d0] = __builtin_amdgcn_mfma_f32_32x32x16_bf16(pa3, (bf16x8){l3[0], l3[1], l3[2], l3[3], h3[0], h3[1], h3[2], h3[3]}, o[d0], 0, 0, 0); } while (0)
    PV_D0(0); PV_D0(1); PV_D0(2); PV_D0(3);
#undef PV_D0
#undef TRRD
}
__device__ __forceinline__ void store_o(const f32x16* o, const float* scl, bf16* Ow, int ld, int r32, int hi) {
#pragma unroll
    for (int r = 0; r < 16; ++r) { const int orow = crow(r, hi);
#pragma unroll
        for (int d0 = 0; d0 < 4; ++d0) { const float v = o[d0][r] * scl[r]; const float vn = __shfl_xor(v, 1);
            if ((r32 & 1) == 0) *(GAS unsigned*)(Ow + (size_t)orow * ld + d0 * 32 + r32) = pk2(v, vn); } }
}
__device__ __forceinline__ void softmax_step(f32x16& p0, f32x16& p1, float& m, float& l, f32x16* o, LAS float* al_l, int r32, int hi) {
    float pmax = p0[0];
#pragma unroll
    for (int r = 1; r < 16; ++r) pmax = fmaxf(pmax, p0[r]);
#pragma unroll
    for (int r = 0; r < 16; ++r) pmax = fmaxf(pmax, p1[r]);
    pmax = pair_max(pmax);
    const float mn = fmaxf(m, pmax);
    const float alpha = __builtin_amdgcn_exp2f(m - mn); m = mn;
    float ps = 0.f;
#pragma unroll
    for (int r = 0; r < 16; ++r) { p0[r] = __builtin_amdgcn_exp2f(p0[r] - mn); ps += p0[r]; }
#pragma unroll
    for (int r = 0; r < 16; ++r) { p1[r] = __builtin_amdgcn_exp2f(p1[r] - mn); ps += p1[r]; }
    ps = pair_sum(ps);
    l = l * alpha + ps;
    if (__any(alpha < 1.f)) {
        if (hi == 0) al_l[r32] = alpha;
        LDS_WAIT();
#pragma unroll
        for (int r = 0; r < 16; ++r) { const float a = al_l[crow(r, hi)];
#pragma unroll
            for (int d = 0; d < 4; ++d) o[d][r] *= a; }
        LDS_WAIT();
    }
}
struct KVStage { bf16x8 k0, k1, v0, v1; };
__device__ __forceinline__ void kv_load(KVStage& s, const bf16* Kp, const bf16* Vp, int ld, int kb0, int sr, int sc) {
    s.k0 = *(const GAS bf16x8*)(Kp + (size_t)(kb0 + sr) * ld + sc); s.k1 = *(const GAS bf16x8*)(Kp + (size_t)(kb0 + 32 + sr) * ld + sc);
    s.v0 = *(const GAS bf16x8*)(Vp + (size_t)(kb0 + sr) * ld + sc); s.v1 = *(const GAS bf16x8*)(Vp + (size_t)(kb0 + 32 + sr) * ld + sc);
}
__device__ __forceinline__ void kv_write(const KVStage& s, LAS char* K_lds, LAS char* V_lds, int sr, int sc) {
    const int kws = KSWZ(sr, sc * 2);
    *(LAS bf16x8*)(K_lds + kws) = s.k0; *(LAS bf16x8*)(K_lds + kws + 32 * 256) = s.k1;
    *(LAS bf16x8*)(V_lds + v_st(sr, sc)) = s.v0; *(LAS bf16x8*)(V_lds + v_st(32 + sr, sc)) = s.v1;
}

__device__ __forceinline__ void moba_unit(LAS char* lds, const bf16* PROJ, const bf16* KMEAN, bf16* AO, int b, int h, int own, int tid) {
    const int wid = __builtin_amdgcn_readfirstlane(tid >> 6), lane = tid & 63, r32 = lane & 31, hi = lane >> 5;
    LAS char* V_lds = lds; LAS char* K_lds = lds + ATT_TILE; LAS float* al_l = (LAS float*)(lds + 2 * ATT_TILE) + wid * 64;
    const int sr = tid >> 4, sc = (tid & 15) * 8;
    const bf16* Kp = PROJ + (size_t)(b * T) * NPROJ + 2048 + h * 128; const bf16* Vp = PROJ + (size_t)(b * T) * NPROJ + 4096 + h * 128;
    const int tq = own * 256 + wid * 32 + r32;
    bf16x8 qr[8];
    { const bf16* qp = PROJ + (size_t)(b * T + tq) * NPROJ + h * 128 + hi * 8;
#pragma unroll
      for (int d0 = 0; d0 < 8; ++d0) qr[d0] = *(const GAS bf16x8*)(qp + d0 * 16); }
    KVStage st; kv_load(st, Kp, Vp, NPROJ, 0, sr, sc);
    __syncthreads();
    { const int row = tid >> 4, chk = tid & 15; bf16x8 v = {0, 0, 0, 0, 0, 0, 0, 0};
      if (row < 16) v = *(const GAS bf16x8*)(KMEAN + ((size_t)((b * 16 + h) * 16 + row)) * 128 + chk * 8);
      *(LAS bf16x8*)(K_lds + KSWZ(row, chk * 16)) = v; }
    __syncthreads();
    unsigned sel = 0u;
    { f32x16 g0; qkt32(g0, K_lds, r32, hi, qr);
      float gate[16];
#pragma unroll
      for (int k = 0; k < 8; ++k) { const int nA = (k & 3) + 8 * (k >> 2), nB = nA + 4; const float mine = g0[k], oth = pair_other(mine, hi);
          gate[nA] = hi ? oth : mine; gate[nB] = hi ? mine : oth; }
      if (own <= 3) sel = (1u << own) - 1u;
      else {
#pragma unroll
          for (int pick = 0; pick < 3; ++pick) { float best = -3.0e38f; int bi = 0;
#pragma unroll
              for (int n = 0; n < 16; ++n) { const bool ok = (n < own) && !((sel >> n) & 1u) && (gate[n] > best); best = ok ? gate[n] : best; bi = ok ? n : bi; }
              sel |= 1u << bi; } } }
    const float slope = exp2f(-0.5f * (float)(h + 1));
    const float C2 = 0.08838834764831845f * 1.4426950408889634f, SL2 = slope * 1.4426950408889634f, SL8 = 8.f * SL2, SL32 = 32.f * SL2;
    float m = -1e30f, l = 0.f; f32x16 o[4] = {};
    const int vb0 = (int)(unsigned)(uintptr_t)V_lds + v_rd_base(lane);
    const int NT = 4 * (own + 1);
    for (int t = 0; t < NT; ++t) {
        __syncthreads();
        kv_write(st, K_lds, V_lds, sr, sc);
        __syncthreads();
        if (t + 1 < NT) kv_load(st, Kp, Vp, NPROJ, (t + 1) * 64, sr, sc);
        const int n = t >> 2; const bool past = n < own;
        const bool mysel = (sel >> n) & 1u;
        const bool act = past ? (__ballot(mysel) != 0ull) : ((t & 3) * 64 <= wid * 32 + 31);
        if (act) {
            f32x16 p0, p1; qkt64(p0, p1, K_lds, r32, hi, qr);
            const int dq = tq - t * 64 - 4 * hi;
            const float NEG = -__builtin_inff();
            float xq_ = -SL2 * (float)dq;
#pragma unroll
            for (int q = 0; q < 4; ++q) { float y = xq_;
#pragma unroll
                for (int i = 0; i < 4; ++i) { const int r = 4 * q + i, c = i + 8 * q;
                    const float s0 = fmaf(p0[r], C2, y), s1 = fmaf(p1[r], C2, y + SL32);
                    const bool ok0 = past ? mysel : (dq >= c), ok1 = past ? mysel : (dq >= c + 32);
                    p0[r] = ok0 ? s0 : NEG; p1[r] = ok1 ? s1 : NEG; y += SL2; }
                xq_ += SL8; }
            softmax_step(p0, p1, m, l, o, al_l, r32, hi);
            bf16x8 pa0, pa1, pa2, pa3; pack_p(p0, p1, pa0, pa1, pa2, pa3);
            pv64(o, vb0, pa0, pa1, pa2, pa3);
        }
    }
    if (hi == 0) al_l[r32] = l; LDS_WAIT();
    float rli[16];
#pragma unroll
    for (int r = 0; r < 16; ++r) rli[r] = 1.0f / al_l[crow(r, hi)];
    LDS_WAIT();
    store_o(o, rli, AO + (size_t)(b * T + own * 256 + wid * 32) * D + h * 128, D, r32, hi);
}

__device__ __forceinline__ void sb_unit(LAS char* lds, const bf16* PROJ, bf16* AO, int b, int h, int blk, int tid) {
    const int wid = __builtin_amdgcn_readfirstlane(tid >> 6), lane = tid & 63, r32 = lane & 31, hi = lane >> 5;
    LAS char* V_lds = lds; LAS char* K_lds = lds + ATT_TILE; LAS unsigned* flags = (LAS unsigned*)(lds + 2 * ATT_TILE + 2048);
    const int sr = tid >> 4, sc = (tid & 15) * 8;
    const bf16* Kp = PROJ + (size_t)(b * T) * NPROJ + 8192 + h * 128; const bf16* Vp = PROJ + (size_t)(b * T) * NPROJ + 10240 + h * 128;
    const int tq = blk * 256 + wid * 32 + r32;
    bf16x8 qr[8];
    { const bf16* qp = PROJ + (size_t)(b * T + tq) * NPROJ + 6144 + h * 128 + hi * 8;
#pragma unroll
      for (int d0 = 0; d0 < 8; ++d0) qr[d0] = *(const GAS bf16x8*)(qp + d0 * 16); }
    int jt = blk * 4 + 3;
    KVStage st; kv_load(st, Kp, Vp, NPROJ, jt * 64, sr, sc);
    float R = 0.f; f32x16 o[4] = {};
    const int vb0 = (int)(unsigned)(uintptr_t)V_lds + v_rd_base(lane);
    const float SCALE = 0.08838834764831845f, L2E = 1.4426950408889634f, LN2 = 0.6931471805599453f;
    bool wdone = false;
    for (;;) {
        __syncthreads();
        kv_write(st, K_lds, V_lds, sr, sc);
        __syncthreads();
        if (jt > 0) kv_load(st, Kp, Vp, NPROJ, (jt - 1) * 64, sr, sc);
        const bool started = jt * 64 <= blk * 256 + wid * 32 + 30;
        if (started && !wdone) {
            const int dq = tq - jt * 64 - 4 * hi;
            bf16x8 pa[4]; float acc = 0.f;
#pragma unroll
            for (int ph = 1; ph >= 0; --ph) {
                f32x16 z; qkt32(z, K_lds + ph * 32 * 256, r32, hi, qr);
                f32x16 Lx; const int dqh = dq - 32 * ph;
#pragma unroll
                for (int r = 0; r < 16; ++r) { const int c = (r & 3) + 8 * (r >> 2);
                    const float zz = z[r] * SCALE; const float sp = fmaxf(zz, 0.f) + LN2 * __builtin_amdgcn_logf(1.0f + __builtin_amdgcn_exp2f(-fabsf(zz) * L2E));
                    const bool strict = dqh > c; Lx[r] = strict ? -sp : 0.f; z[r] = zz - sp; }
#pragma unroll
                for (int q = 3; q >= 0; --q) { const float mine = (Lx[4 * q] + Lx[4 * q + 1]) + (Lx[4 * q + 2] + Lx[4 * q + 3]);
                    unsigned a_, b_; pair_get(__float_as_uint(mine), a_, b_); const float s_lo = __uint_as_float(a_), s_hi = __uint_as_float(b_);
                    const float bs = R + (hi ? acc : (acc + s_hi)); acc += s_hi + s_lo;
                    const float l3 = Lx[4 * q + 3], l2 = Lx[4 * q + 2], l1 = Lx[4 * q + 1];
                    const float e3 = bs, e2 = bs + l3, e1 = e2 + l2, e0 = e1 + l1;
                    const int dd = dqh - 8 * q;
                    z[4 * q + 0] = (dd > 0) ? __builtin_amdgcn_exp2f((z[4 * q + 0] + e0) * L2E) : 0.f;
                    z[4 * q + 1] = (dd > 1) ? __builtin_amdgcn_exp2f((z[4 * q + 1] + e1) * L2E) : 0.f;
                    z[4 * q + 2] = (dd > 2) ? __builtin_amdgcn_exp2f((z[4 * q + 2] + e2) * L2E) : 0.f;
                    z[4 * q + 3] = (dd > 3) ? __builtin_amdgcn_exp2f((z[4 * q + 3] + e3) * L2E) : 0.f; }
#define PK4(P, B_, OUT) do { unsigned a0 = cvtpk(P[B_+0], P[B_+1]), a1 = cvtpk(P[B_+2], P[B_+3]);                          \
        unsigned b0 = cvtpk(P[B_+4], P[B_+5]), b1 = cvtpk(P[B_+6], P[B_+7]);                                             \
        auto r0 = __builtin_amdgcn_permlane32_swap(a0, b0, false, false); auto r1 = __builtin_amdgcn_permlane32_swap(a1, b1, false, false); \
        v4u w = {r0[0], r1[0], r0[1], r1[1]}; OUT = __builtin_bit_cast(bf16x8, w); } while (0)
                PK4(z, 0, pa[2 * ph]); PK4(z, 8, pa[2 * ph + 1]);
#undef PK4
            }
            R += acc;
            pv64(o, vb0, pa[0], pa[1], pa[2], pa[3]);
            wdone = __all(R < -110.f);
        }
        if (lane == 0) flags[wid] = wdone ? 1u : 0u;
        __syncthreads();
        bool alld = true;
#pragma unroll
        for (int w = 0; w < 8; ++w) alld = alld && (flags[w] != 0u);
        if (jt == 0 || alld) break;
        --jt;
    }
    float one[16];
#pragma unroll
    for (int r = 0; r < 16; ++r) one[r] = 1.0f;
    store_o(o, one, AO + (size_t)(b * T + blk * 256 + wid * 32) * D + 2048 + h * 128, D, r32, hi);
}

__device__ __forceinline__ void xattn_unit(LAS char* lds, const bf16* XQ, const bf16* KVMEM, const float* gq, const float* gk, bf16* XO, int b, int xh, int blk, int tid) {
    const int wid = __builtin_amdgcn_readfirstlane(tid >> 6), lane = tid & 63, r32 = lane & 31, hi = lane >> 5;
    LAS char* V_lds = lds; LAS char* K_lds = lds + ATT_TILE; LAS float* al_l = (LAS float*)(lds + 2 * ATT_TILE) + wid * 64;
    const int sr = tid >> 4, sc = (tid & 15) * 8;
    const bf16* Kp = KVMEM + (size_t)(b * NMEM) * 1024 + xh * 128; const bf16* Vp = KVMEM + (size_t)(b * NMEM) * 1024 + 512 + xh * 128;
    const int row = b * T + blk * 256 + wid * 32 + r32;
    bf16x8 qr[8];
    { const bf16* qp = XQ + (size_t)row * XW + xh * 128 + hi * 8;
      v4u raw[8]; float ss = 0.f;
#pragma unroll
      for (int d0 = 0; d0 < 8; ++d0) { raw[d0] = *(const GAS v4u*)(qp + d0 * 16);
          const float x[8] = {bflo(raw[d0].x), bfhi(raw[d0].x), bflo(raw[d0].y), bfhi(raw[d0].y), bflo(raw[d0].z), bfhi(raw[d0].z), bflo(raw[d0].w), bfhi(raw[d0].w)};
#pragma unroll
          for (int k = 0; k < 8; ++k) ss += x[k] * x[k]; }
      ss = pair_sum(ss);
      const float r = 1.0f / sqrtf(ss * (1.f / 128.f) + RMS_EPS);
#pragma unroll
      for (int d0 = 0; d0 < 8; ++d0) { const float* g = gq + d0 * 16 + hi * 8; const f32x4 ga = *(const GAS f32x4*)g, gb = *(const GAS f32x4*)(g + 4);
          v4u w; w.x = pk2(bflo(raw[d0].x) * r * ga.x, bfhi(raw[d0].x) * r * ga.y); w.y = pk2(bflo(raw[d0].y) * r * ga.z, bfhi(raw[d0].y) * r * ga.w);
          w.z = pk2(bflo(raw[d0].z) * r * gb.x, bfhi(raw[d0].z) * r * gb.y); w.w = pk2(bflo(raw[d0].w) * r * gb.z, bfhi(raw[d0].w) * r * gb.w);
          qr[d0] = __builtin_bit_cast(bf16x8, w); } }
    float gkk[8];
#pragma unroll
    for (int j = 0; j < 8; ++j) gkk[j] = gk[sc + j];
    const float C2 = 0.08838834764831845f * 1.4426950408889634f;
    float m = -1e30f, l = 0.f; f32x16 o[4] = {};
    const int vb0 = (int)(unsigned)(uintptr_t)V_lds + v_rd_base(lane);
    KVStage st; kv_load(st, Kp, Vp, 1024, 0, sr, sc);
    for (int t = 0; t < 4; ++t) {
        { v4u w0 = __builtin_bit_cast(v4u, st.k0), w1 = __builtin_bit_cast(v4u, st.k1);
          float x0[8] = {bflo(w0.x), bfhi(w0.x), bflo(w0.y), bfhi(w0.y), bflo(w0.z), bfhi(w0.z), bflo(w0.w), bfhi(w0.w)};
          float x1[8] = {bflo(w1.x), bfhi(w1.x), bflo(w1.y), bfhi(w1.y), bflo(w1.z), bfhi(w1.z), bflo(w1.w), bfhi(w1.w)};
          float s0 = 0.f, s1 = 0.f;
#pragma unroll
          for (int k = 0; k < 8; ++k) { s0 += x0[k] * x0[k]; s1 += x1[k] * x1[k]; }
          s0 += __shfl_xor(s0, 1); s0 += __shfl_xor(s0, 2); s0 += __shfl_xor(s0, 4); s0 += __shfl_xor(s0, 8);
          s1 += __shfl_xor(s1, 1); s1 += __shfl_xor(s1, 2); s1 += __shfl_xor(s1, 4); s1 += __shfl_xor(s1, 8);
          const float r0 = 1.0f / sqrtf(s0 * (1.f / 128.f) + RMS_EPS), r1 = 1.0f / sqrtf(s1 * (1.f / 128.f) + RMS_EPS);
          w0.x = pk2(x0[0] * r0 * gkk[0], x0[1] * r0 * gkk[1]); w0.y = pk2(x0[2] * r0 * gkk[2], x0[3] * r0 * gkk[3]); w0.z = pk2(x0[4] * r0 * gkk[4], x0[5] * r0 * gkk[5]); w0.w = pk2(x0[6] * r0 * gkk[6], x0[7] * r0 * gkk[7]);
          w1.x = pk2(x1[0] * r1 * gkk[0], x1[1] * r1 * gkk[1]); w1.y = pk2(x1[2] * r1 * gkk[2], x1[3] * r1 * gkk[3]); w1.z = pk2(x1[4] * r1 * gkk[4], x1[5] * r1 * gkk[5]); w1.w = pk2(x1[6] * r1 * gkk[6], x1[7] * r1 * gkk[7]);
          st.k0 = __builtin_bit_cast(bf16x8, w0); st.k1 = __builtin_bit_cast(bf16x8, w1); }
        __syncthreads();
        kv_write(st, K_lds, V_lds, sr, sc);
        __syncthreads();
        if (t + 1 < 4) kv_load(st, Kp, Vp, 1024, (t + 1) * 64, sr, sc);
        f32x16 p0, p1; qkt64(p0, p1, K_lds, r32, hi, qr);
#pragma unroll
        for (int r = 0; r < 16; ++r) { p0[r] *= C2; p1[r] *= C2; }
        softmax_step(p0, p1, m, l, o, al_l, r32, hi);
        bf16x8 pa0, pa1, pa2, pa3; pack_p(p0, p1, pa0, pa1, pa2, pa3);
        pv64(o, vb0, pa0, pa1, pa2, pa3);
    }
    if (hi == 0) al_l[r32] = l; LDS_WAIT();
    float rli[16];
#pragma unroll
    for (int r = 0; r < 16; ++r) rli[r] = 1.0f / al_l[crow(r, hi)];
    LDS_WAIT();
    store_o(o, rli, XO + (size_t)(b * T + blk * 256 + wid * 32) * XW + xh * 128, XW, r32, hi);
    __syncthreads();
}

__device__ __forceinline__ unsigned f2ord(float f) { const unsigned u = __float_as_uint(f); return u ^ ((u >> 31) ? 0xffffffffu : 0x80000000u); }
__device__ __forceinline__ float ord2f(unsigned k) { return __uint_as_float(k ^ ((k >> 31) ? 0x80000000u : 0xffffffffu)); }
__device__ __forceinline__ void cnt_ge(int& cnt, unsigned key, unsigned T) { asm volatile("v_cmp_ge_u32_e32 vcc, %1, %2\n\tv_addc_co_u32_e32 %0, vcc, 0, %0, vcc" : "+v"(cnt) : "v"(key), "v"(T) : "vcc"); }
__device__ __forceinline__ void cnt_gt(int& cnt, unsigned key, unsigned T) { asm volatile("v_cmp_gt_u32_e32 vcc, %1, %2\n\tv_addc_co_u32_e32 %0, vcc, 0, %0, vcc" : "+v"(cnt) : "v"(key), "v"(T) : "vcc"); }
__device__ __forceinline__ void cnt_eq(int& cnt, unsigned key, unsigned T) { asm volatile("v_cmp_eq_u32_e32 vcc, %1, %2\n\tv_addc_co_u32_e32 %0, vcc, 0, %0, vcc" : "+v"(cnt) : "v"(key), "v"(T) : "vcc"); }
template <int N> __device__ __forceinline__ unsigned pair_kth(const unsigned (&key)[N], int need) {
    unsigned Tv = 0u;
#pragma unroll 1
    for (int b = 31; b >= 0; --b) { const unsigned Tt = Tv | (1u << b); int cnt = 0;
#pragma unroll
        for (int i = 0; i < N; ++i) cnt_ge(cnt, key[i], Tt);
        cnt = pair_sumi(cnt);
        Tv = (cnt >= need) ? Tt : Tv; }
    return Tv;
}
__device__ __forceinline__ void peer_route_unit(LAS char* lds, const bf16* PQ, const bf16* SUBK, bf16* G, int tile, int hp, int tid) {
    const int wid = __builtin_amdgcn_readfirstlane(tid >> 6), lane = tid & 63, r32 = lane & 31, hi = lane >> 5;
    LAS char* SK = lds;
    LAS unsigned* lists = (LAS unsigned*)(lds + 65536) + wid * 1024;
    LAS unsigned* dummy = (LAS unsigned*)(lds + 65536 + 32768) + wid * 128 + 2 * lane;
    LAS v2u* fin = (LAS v2u*)lists + r32 * 16;
    __syncthreads();
#pragma unroll
    for (int i = 0; i < 8; ++i) { const int q = tid + 512 * i; const int half = q >> 11, key = (q >> 4) & 127, chk = q & 15;
        const bf16x8 v = *(const GAS bf16x8*)(SUBK + ((size_t)((hp * 2 + half) * 128 + key)) * 128 + chk * 8);
        *(LAS bf16x8*)(SK + half * 32768 + KSWZ(key, chk * 16)) = v; }
    __syncthreads();
    const int token = tile * 256 + wid * 32 + r32;
#pragma unroll 1
    for (int half = 0; half < 2; ++half) {
        bf16x8 qr[8];
        { const bf16* qp = PQ + (size_t)token * PQW + hp * 256 + half * 128 + hi * 8;
#pragma unroll
          for (int d0 = 0; d0 < 8; ++d0) qr[d0] = *(const GAS bf16x8*)(qp + d0 * 16); }
        unsigned key[64];
#pragma unroll
        for (int kg = 0; kg < 4; ++kg) { f32x16 s = f32x16{};
            const LAS char* kt = SK + half * 32768 + kg * 32 * 256;
#pragma unroll
            for (int d0 = 0; d0 < 8; ++d0) { const bf16x8 a = *(const LAS bf16x8*)(kt + KSWZ(r32, (d0 * 16 + hi * 8) * 2)); s = __builtin_amdgcn_mfma_f32_32x32x16_bf16(a, qr[d0], s, 0, 0, 0); }
#pragma unroll
            for (int r = 0; r < 16; ++r) { const int kidx = kg * 32 + (r & 3) + 8 * (r >> 2);
                key[kg * 16 + r] = (f2ord(s[r]) & ~127u) | (unsigned)(127 - (kidx + 4 * hi)); } }
        const unsigned Tv = pair_kth<64>(key, 16);
        int mycnt = 0;
#pragma unroll
        for (int i = 0; i < 64; ++i) cnt_ge(mycnt, key[i], Tv);
        unsigned c0, c1; pair_get((unsigned)mycnt, c0, c1);
        int pos = hi ? (int)c0 : 0;
        LAS unsigned* lst = lists + (half * 32 + r32) * 16;
#pragma unroll
        for (int i = 0; i < 64; ++i) { const bool tk = key[i] >= Tv; LAS unsigned* dst = tk ? (lst + (pos & 15)) : dummy; *dst = key[i]; pos += tk ? 1 : 0;
            if ((i & 7) == 7) SBAR(); }
    }
    LDS_WAIT();
    unsigned ka[16], kb[8];
    { const LAS unsigned* la = lists + (0 * 32 + r32) * 16; const LAS unsigned* lb = lists + (1 * 32 + r32) * 16 + 8 * hi;
#pragma unroll
      for (int i = 0; i < 16; ++i) ka[i] = la[i];
#pragma unroll
      for (int j = 0; j < 8; ++j) kb[j] = lb[j]; }
    float va[16], vb[8];
#pragma unroll
    for (int i = 0; i < 16; ++i) va[i] = ord2f(ka[i] & ~127u);
#pragma unroll
    for (int j = 0; j < 8; ++j) vb[j] = ord2f(kb[j] & ~127u);
    unsigned sk[128];
#pragma unroll
    for (int i = 0; i < 16; ++i)
#pragma unroll
        for (int j = 0; j < 8; ++j) sk[i * 8 + j] = f2ord(va[i] + vb[j]);
    const unsigned T2 = pair_kth<128>(sk, 16);
    int ngt = 0, neq = 0;
#pragma unroll
    for (int i = 0; i < 128; ++i) { cnt_gt(ngt, sk[i], T2); cnt_eq(neq, sk[i], T2); }
    unsigned g0, g1, e0, e1; pair_get((unsigned)ngt, g0, g1); pair_get((unsigned)neq, e0, e1);
    int iaS[16], ibv[8];
#pragma unroll
    for (int i = 0; i < 16; ++i) iaS[i] = (127 - (int)(ka[i] & 127u)) * 128;
#pragma unroll
    for (int j = 0; j < 8; ++j) ibv[j] = 127 - (int)(kb[j] & 127u);
    { int pos = hi ? (int)g0 : 0;
#pragma unroll
      for (int i = 0; i < 128; ++i) { const bool tk = sk[i] > T2; LAS v2u* dst = tk ? (fin + (pos & 15)) : (LAS v2u*)dummy; v2u ent; ent.x = sk[i]; ent.y = (unsigned)(iaS[i >> 3] + ibv[i & 7]); *dst = ent; pos += tk ? 1 : 0;
          if ((i & 7) == 7) SBAR(); }
      pos = (int)(g0 + g1) + (hi ? (int)e0 : 0);
#pragma unroll
      for (int i = 0; i < 16; ++i) asm volatile("" : "+v"(iaS[i]));
#pragma unroll
      for (int i = 0; i < 128; ++i) { const bool tk = (sk[i] == T2) && (pos < 16); LAS v2u* dst = tk ? (fin + (pos & 15)) : (LAS v2u*)dummy; v2u ent; ent.x = sk[i]; ent.y = (unsigned)(iaS[i >> 3] + ibv[i & 7]); *dst = ent; pos += (sk[i] == T2) ? 1 : 0;
          if ((i & 7) == 7) SBAR(); } }
    LDS_WAIT();
    v2u ent[8]; float sv[8]; float smax = -3.0e38f;
#pragma unroll
    for (int k = 0; k < 8; ++k) { ent[k] = fin[8 * hi + k]; sv[k] = ord2f(ent[k].x); smax = fmaxf(smax, sv[k]); }
    smax = pair_max(smax);
    float wsum = 0.f;
#pragma unroll
    for (int k = 0; k < 8; ++k) { sv[k] = __builtin_amdgcn_exp2f((sv[k] - smax) * 1.4426950408889634f); wsum += sv[k]; }
    wsum = pair_sum(wsum);
    const float rinv = 1.0f / wsum;
    bf16* Grow = G + (size_t)token * NEXP;
#pragma unroll
    for (int k = 0; k < 8; ++k) { const int e = (int)ent[k].y; const unsigned gb = f2bf(sv[k] * rinv);
        v2s val; val.x = (e & 1) ? (short)0 : (short)gb; val.y = (e & 1) ? (short)gb : (short)0;
        __builtin_amdgcn_global_atomic_fadd_v2bf16((GAS v2s*)(Grow + (e & ~1)), val); }
}

struct Args { const float* in[21]; float* out; unsigned char* ws; };
enum { I_X = 0, I_MEM, I_NORM_MIX_G, I_W_IN, I_MOBA_QG, I_MOBA_KG, I_MOBA_OG, I_SB_OG, I_W_OUT, I_NORM_XG, I_NORM_MEMG, I_W_XQ, I_W_XKV, I_XQG, I_XKG, I_W_XO, I_NORM_FG, I_W_PQ, I_SUBK, I_U, I_V };

__global__ void __launch_bounds__(NWAVES * 64, 2) mk_fwd(Args args) {
    extern __shared__ __attribute__((aligned(16))) unsigned char lds_raw[];
    LAS unsigned char* lds = (LAS unsigned char*)lds_raw;
    volatile LAS unsigned* MISC = (volatile LAS unsigned*)(lds + MISC_OFF);
    const int tid = threadIdx.x, lane = tid & 63, wave = __builtin_amdgcn_readfirstlane(tid >> 6);
    const int G = gridDim.x, bx = blockIdx.x;
    unsigned* ctl = (unsigned*)(args.ws + WS_CTL);
    for (int u = tid; u < (LDS_BYTES - RING_BYTES) / 4; u += NWAVES * 64) ((LAS unsigned*)(lds + RING_BYTES))[u] = 0u;
    __syncthreads();
    XcdBarrier bar = xcd_barrier_post(ctl + CW_BAR, MISC + 8);

    if (tid == 0) {
#pragma unroll
        for (int i = 0; i < 21; ++i) { const unsigned long long p = (unsigned long long)args.in[i]; MISC[16 + 2 * i] = (unsigned)p; MISC[17 + 2 * i] = (unsigned)(p >> 32); }
        { const unsigned long long p = (unsigned long long)args.out; MISC[16 + 42] = (unsigned)p; MISC[17 + 42] = (unsigned)(p >> 32); }
        { const unsigned long long p = (unsigned long long)args.ws; MISC[16 + 44] = (unsigned)p; MISC[17 + 44] = (unsigned)(p >> 32); }
    }
    __syncthreads();
#define PTR(i) ((const float*)(((unsigned long long)(unsigned)__builtin_amdgcn_readfirstlane((int)MISC[17 + 2 * (i)]) << 32) | (unsigned long long)(unsigned)__builtin_amdgcn_readfirstlane((int)MISC[16 + 2 * (i)])))
#define OUTP ((float*)PTR(21))
#define WSP(off) ((bf16*)((unsigned char*)PTR(22) + (off)))
#define GW (bx * NWAVES + wave)
#define NGW (G * NWAVES)
#define GTID ((size_t)bx * (NWAVES * 64) + tid)
#define GTHREADS ((size_t)G * (NWAVES * 64))
    {
        LAS float* scr = (LAS float*)(lds + wave * 16384);
        constexpr int I_IN = (D / 64) * (NPROJ / 32), I_OUT = (D / 64) * (D / 32), I_XQ = (D / 64) * (XW / 32), I_XKV = (D / 64) * (2 * XW / 32), I_XO = (XW / 64) * (D / 32),
                      I_PQ = (D / 64) * (PQW / 32), I_VV = (NEXP / 64) * (D / 32);
        constexpr int NITEMS = I_IN + I_OUT + I_XQ + I_XKV + I_XO + I_PQ + I_VV;
        { const float* pV = PTR(I_V); const float* pIN = PTR(I_W_IN); const float* pOUT = PTR(I_W_OUT); const float* pPQ = PTR(I_W_PQ); const float* pXKV = PTR(I_W_XKV); const float* pXQ = PTR(I_W_XQ); const float* pXO = PTR(I_W_XO);
          unsigned char* wsb = (unsigned char*)PTR(22);
          for (int it = GW; it < NITEMS; it += NGW) {
            int r = it;
            if (r < I_VV) { p0_transpose_item(pV, NEXP, D, (bf16*)(wsb + WS_VT), scr, r, lane); continue; } r -= I_VV;
            if (r < I_IN) { p0_transpose_item(pIN, D, NPROJ, (bf16*)(wsb + WS_WIN), scr, r, lane); continue; } r -= I_IN;
            if (r < I_OUT) { p0_transpose_item(pOUT, D, D, (bf16*)(wsb + WS_WOUT), scr, r, lane); continue; } r -= I_OUT;
            if (r < I_PQ) { p0_transpose_item(pPQ, D, PQW, (bf16*)(wsb + WS_WPQ), scr, r, lane); continue; } r -= I_PQ;
            if (r < I_XKV) { p0_transpose_item(pXKV, D, 2 * XW, (bf16*)(wsb + WS_WXKV), scr, r, lane); continue; } r -= I_XKV;
            if (r < I_XQ) { p0_transpose_item(pXQ, D, XW, (bf16*)(wsb + WS_WXQ), scr, r, lane); continue; } r -= I_XQ;
            p0_transpose_item(pXO, XW, D, (bf16*)(wsb + WS_WXO), scr, r, lane);
          } }
        cvt_f32_bf16(PTR(I_U), WSP(WS_U), (size_t)NEXP * D, GTID, GTHREADS);
        cvt_f32_bf16(PTR(I_SUBK), WSP(WS_SUBK), (size_t)8 * 2 * 128 * 128, GTID, GTHREADS);
        { const float* px = PTR(I_X); const float* pg = PTR(I_NORM_MIX_G); bf16* ph = WSP(WS_H);
          for (int m = GW; m < M; m += NGW) rms_row_4096(px + (size_t)m * D, pg, ph + (size_t)m * D, lane); }
        { const float* px = PTR(I_MEM); const float* pg = PTR(I_NORM_MEMG); bf16* ph = WSP(WS_MEMN);
          for (int m = GW; m < NB * NMEM; m += NGW) rms_row_4096(px + (size_t)m * D, pg, ph + (size_t)m * D, lane); }
    }
    xcd_barrier(bar);

    {
        pg8::Gemm g{WSP(WS_H), WSP(WS_WIN), M, NPROJ, D}; pg8::StaticOrder S; S.init(M, NPROJ, G, bx);
        pg8::EpiBf16<0> E{WSP(WS_PROJ), NPROJ, nullptr, 0, 0, 1.f};
        pg8::gemm_phase<pg8::EpiBf16<0>, pg8::StaticOrder, true, true>(lds, g, S, E);
    }
    xcd_barrier(bar);

    for (int u = bx; u < 2048; u += G) {
        const int which = u & 1, h = (u >> 1) & 15, blk = (u >> 5) & 15, b = u >> 9;
        qknorm_unit(WSP(WS_PROJ), b * T + blk * 256, which * 2048 + h * 128, which ? PTR(I_MOBA_KG) : PTR(I_MOBA_QG),
                    which ? WSP(WS_KMEAN) + ((size_t)((b * 16 + h) * 16 + blk)) * 128 : nullptr, (LAS float*)lds, tid);
    }
    xcd_barrier(bar);

    for (int p = bx; p < 512; p += G) {
        const int bh = p >> 3, oo = p & 7;
        moba_unit((LAS char*)lds, WSP(WS_PROJ), WSP(WS_KMEAN), WSP(WS_AO), bh >> 4, bh & 15, 15 - oo, tid);
        moba_unit((LAS char*)lds, WSP(WS_PROJ), WSP(WS_KMEAN), WSP(WS_AO), bh >> 4, bh & 15, oo, tid);
    }
    for (int u = bx; u < 1024; u += G) { const int bh = u >> 4, blk = u & 15; sb_unit((LAS char*)lds, WSP(WS_PROJ), WSP(WS_AO), bh >> 4, bh & 15, blk, tid); }
    xcd_barrier(bar);

    { bf16* pa = WSP(WS_AO); const float* g1 = PTR(I_MOBA_OG); const float* g2 = PTR(I_SB_OG);
      for (int m = GW; m < M; m += NGW) outnorm_row(pa + (size_t)m * D, g1, g2, lane); }
    xcd_barrier(bar);

    {
        pg8::Gemm g{WSP(WS_AO), WSP(WS_WOUT), M, D, D}; pg8::StaticOrder S; S.init(M, D, G, bx);
        pg8::EpiF32Res E{PTR(I_X), OUTP, D};
        pg8::gemm_phase<pg8::EpiF32Res, pg8::StaticOrder, true, true>(lds, g, S, E);
    }
    xcd_barrier(bar);

    { const float* px = OUTP; const float* pg = PTR(I_NORM_XG); bf16* ph = WSP(WS_H);
      for (int m = GW; m < M; m += NGW) rms_row_4096(px + (size_t)m * D, pg, ph + (size_t)m * D, lane); }
    { const v4u z = {0u, 0u, 0u, 0u}; GAS v4u* gp = (GAS v4u*)WSP(WS_GATE); const size_t n16 = (size_t)M * NEXP * 2 / 16;
      const size_t gs_ = GTHREADS; for (size_t i = GTID; i < n16; i += gs_) gp[i] = z; }
    xcd_barrier(bar);

    {
        pg8::Gemm g{WSP(WS_H), WSP(WS_WXQ), M, XW, D}; pg8::StaticOrder S; S.init(M, XW, G, bx);
        pg8::EpiBf16<0> E{WSP(WS_XQ), XW, nullptr, 0, 0, 1.f};
        pg8::gemm_phase<pg8::EpiBf16<0>, pg8::StaticOrder, true, true>(lds, g, S, E);
    }
    {
        const int c = (G >= 160) ? bx - 128 : bx;
        if (c >= 0) {
            pg8::Gemm g{WSP(WS_MEMN), WSP(WS_WXKV), NB * NMEM, 2 * XW, D}; pg8::StaticOrder S; S.init(NB * NMEM, 2 * XW, G, c);
            pg8::EpiBf16<0> E{WSP(WS_KVMEM), 2 * XW, nullptr, 0, 0, 1.f};
            pg8::gemm_phase<pg8::EpiBf16<0>, pg8::StaticOrder, true, true>(lds, g, S, E);
        }
    }
    xcd_barrier(bar);

    for (int u = bx; u < 256; u += G) xattn_unit((LAS char*)lds, WSP(WS_XQ), WSP(WS_KVMEM), PTR(I_XQG), PTR(I_XKG), WSP(WS_XO), u >> 6, (u >> 4) & 3, u & 15, tid);
    xcd_barrier(bar);

    {
        pg8::Gemm g{WSP(WS_XO), WSP(WS_WXO), M, D, XW}; pg8::StaticOrder S; S.init(M, D, G, bx);
        pg8::EpiF32Res E{OUTP, OUTP, D};
        pg8::gemm_phase<pg8::EpiF32Res, pg8::StaticOrder, true, true>(lds, g, S, E);
    }
    xcd_barrier(bar);

    { const float* px = OUTP; const float* pg = PTR(I_NORM_FG); bf16* ph = WSP(WS_H);
      for (int m = GW; m < M; m += NGW) rms_row_4096(px + (size_t)m * D, pg, ph + (size_t)m * D, lane); }
    xcd_barrier(bar);

    {
        pg8::Gemm g{WSP(WS_H), WSP(WS_WPQ), M, PQW, D}; pg8::StaticOrder S; S.init(M, PQW, G, bx);
        pg8::EpiBf16<0> E{WSP(WS_PQ), PQW, nullptr, 0, 0, 1.f};
        pg8::gemm_phase<pg8::EpiBf16<0>, pg8::StaticOrder, true, true>(lds, g, S, E);
    }
    xcd_barrier(bar);

    for (int u = bx; u < 512; u += G) peer_route_unit((LAS char*)lds, WSP(WS_PQ), WSP(WS_SUBK), WSP(WS_GATE), u >> 3, u & 7, tid);
    xcd_barrier(bar);

    {
        pg8::Gemm g{WSP(WS_H), WSP(WS_U), M, NEXP, D}; pg8::StaticOrder S; S.init(M, NEXP, G, bx);
        pg8::EpiGate E{WSP(WS_GATE), NEXP};
        pg8::gemm_phase<pg8::EpiGate, pg8::StaticOrder, true, true>(lds, g, S, E);
    }
    xcd_barrier(bar);

    {
        pg8::Gemm g{WSP(WS_GATE), WSP(WS_VT), M, D, NEXP}; pg8::StaticOrder S; S.init(M, D, G, bx);
        pg8::EpiF32Res E{OUTP, OUTP, D};
        pg8::gemm_phase<pg8::EpiF32Res, pg8::StaticOrder, true, true>(lds, g, S, E);
    }
}

extern "C" void kernel_launch(void* const* d_in, const int* in_sizes, int n_in, void* d_out, int out_size, void* d_ws, size_t ws_size, hipStream_t stream) {
    static int grid = 0;
    if (grid == 0) {
        if (n_in != 21 || in_sizes[0] != M * D || out_size != M * D || ws_size < WS_END) { fprintf(stderr, "kernel_launch: unexpected shapes (n_in %d, in0 %d, out %d, ws %zu); nothing launched\n", n_in, n_in > 0 ? in_sizes[0] : -1, out_size, ws_size); grid = -1; return; }
        int dev = 0, cus = 0;
        if (hipGetDevice(&dev) != hipSuccess || hipDeviceGetAttribute(&cus, hipDeviceAttributeMultiprocessorCount, dev) != hipSuccess) { grid = -1; return; }
        if (hipFuncSetAttribute((const void*)mk_fwd, hipFuncAttributeMaxDynamicSharedMemorySize, LDS_BYTES) != hipSuccess) { fprintf(stderr, "kernel_launch: hipFuncSetAttribute failed\n"); grid = -1; return; }
        int per_cu = 0;
        if (hipOccupancyMaxActiveBlocksPerMultiprocessor(&per_cu, (const void*)mk_fwd, NWAVES * 64, LDS_BYTES) != hipSuccess || per_cu < 1) fprintf(stderr, "kernel_launch: occupancy query reports %d\n", per_cu);
        (void)hipGetLastError();
        grid = cus;
    }
    if (grid < 0) return;
    if (hipMemsetAsync((char*)d_ws + WS_CTL, 0, CTL_ZERO_BYTES, stream) != hipSuccess) return;
    Args a{};
    for (int i = 0; i < 21; ++i) a.in[i] = (const float*)d_in[i];
    a.out = (float*)d_out; a.ws = (unsigned char*)d_ws;
    hipLaunchKernelGGL(mk_fwd, dim3(grid), dim3(NWAVES * 64), LDS_BYTES, stream, a);
}
```

```cpp
#include <hip/hip_runtime.h>
#include <cstdio>
#include <cstdint>
namespace pg8 {
#define PG8_LAS __attribute__((address_space(3)))
typedef unsigned short bf16_t;
typedef short bf16x8 __attribute__((ext_vector_type(8)));
typedef float f32x4 __attribute__((ext_vector_type(4)));
typedef unsigned u32x4 __attribute__((ext_vector_type(4)));
constexpr int BM = 256, BK = 64, HALF = 128, HTB = HALF * BK * 2  , STAGE_BYTES = 8 * HTB, NXCD = 8, WGM = 8;

__host__ __device__ __forceinline__ int lds_byte(int r, int c) { const int st = (r >> 4) * 2 + (c >> 5), rr = r & 15, cc = c & 31, ob = rr * 64 + cc * 2; return st * 1024 + (ob ^ (((ob >> 9) & 1) << 5)); }
__host__ __device__ __forceinline__ void stage_rc(int b, int& R, int& C) { const int st = b / 1024, sb = b % 1024, swz = sb ^ (((sb >> 9) & 1) << 5); R = (st >> 1) * 16 + swz / 64; C = (st & 1) * 32 + (swz % 64) / 2; }
__host__ __device__ __forceinline__ int perm32(int rho) { const int n = rho >> 4, i = rho & 15; return 8 * (i >> 2) + 4 * n + (i & 3); }

struct Unit { int pm, pn; };
struct Gemm { const bf16_t* A; const bf16_t* Bt; int M, N, K, lda, ldb; };

struct StaticOrder {
    int nM, nN, nwg, G, c;
    __host__ __device__ void init(int M, int N, int G_, int c_) { nM = M / BM; nN = N / BM; nwg = nM * nN; G = G_; c = c_; }
    __host__ __device__ bool next(int i, Unit& u) const {
        const long L = (long)i * G + c; if (L >= nwg) return false;
        int wgid = (int)L; { const int q = nwg / NXCD, r = nwg % NXCD, xcd = wgid % NXCD, off = wgid / NXCD; wgid = (xcd < r ? xcd * (q + 1) : r * (q + 1) + (xcd - r) * q) + off; }
        const int nig = WGM * nN, gid = wgid / nig, fm = gid * WGM, gsz = (nM - fm) < WGM ? (nM - fm) : WGM;
        u.pm = fm + ((wgid % nig) % gsz); u.pn = (wgid % nig) / gsz; return true;
    }
    __device__ __forceinline__ void a_ready(const Unit&) const {}
    __device__ __forceinline__ void done(const Unit&) const {}
};

__device__ __forceinline__ unsigned cvt_pk_bf16(float lo, float hi) { unsigned r; asm volatile("v_cvt_pk_bf16_f32 %0, %1, %2" : "=v"(r) : "v"(lo), "v"(hi)); return r; }
typedef float f32x2 __attribute__((ext_vector_type(2)));
__device__ __forceinline__ f32x2 gelu_pk(f32x2 v) {
    const f32x2 av = __builtin_elementwise_abs(v), d = av * 0.2316418882f + 1.0f;
    f32x2 t; t.x = __builtin_amdgcn_rcpf(d.x); t.y = __builtin_amdgcn_rcpf(d.y);
    f32x2 q = t * 0.5307027145f + (-0.7265760135f); q = q * t + 0.7107068705f; q = q * t + (-0.142248368f); q = q * t + 0.127414796f; q = q * t;
    const f32x2 s = (v * v) * (-0.72134752044f);
    f32x2 e; e.x = __builtin_amdgcn_exp2f(s.x); e.y = __builtin_amdgcn_exp2f(s.y);
    const f32x2 m = v * (q * e), r = v - m;
    f32x2 o; o.x = v.x < 0.f ? m.x : r.x; o.y = v.y < 0.f ? m.y : r.y; return o;
}

template <int ACT  > struct EpiBf16 {
    static constexpr bool PERM = true, AFTER_DRAIN = false; static_assert(ACT == 0 || ACT == 1, "EpiBf16: ACT is 0 (none) or 1 (gelu_pk)");
    bf16_t* O; int ldc; const float* bias; int split_cols; size_t split_stride; float scale0;
    __device__ __forceinline__ void operator()(const f32x4 (&acc)[2][2][4][2], const Unit& u, int wr, int wc, int fr, int fq) const {
        const int row0 = u.pm * BM + wr * 64 + fr; int colt = u.pn * BM; bf16_t* base = O;
        float sc = 1.f; if (split_cols) { const int t = colt / split_cols; base += (size_t)t * split_stride; colt -= t * split_cols; if (t == 0) sc = scale0; }
        const int col0 = colt + wc * 32 + 8 * fq, bcol0 = u.pn * BM + wc * 32 + 8 * fq;
        f32x4 bv[2][2];
#pragma unroll
        for (int bj = 0; bj < 2; ++bj)
#pragma unroll
            for (int n = 0; n < 2; ++n) bv[bj][n] = bias ? *(const f32x4*)(bias + bcol0 + bj * HALF + 4 * n) : (f32x4){0.f, 0.f, 0.f, 0.f};
#pragma unroll
        for (int ai = 0; ai < 2; ++ai)
#pragma unroll
            for (int m = 0; m < 4; ++m) { bf16_t* rowp = base + (size_t)(row0 + ai * HALF + m * 16) * ldc + col0;
#pragma unroll
                for (int bj = 0; bj < 2; ++bj) { f32x4 v0 = acc[ai][bj][m][0] + bv[bj][0], v1 = acc[ai][bj][m][1] + bv[bj][1];
                    if (ACT == 1) { f32x2 a = gelu_pk((f32x2){v0[0], v0[1]}), b = gelu_pk((f32x2){v0[2], v0[3]}), c = gelu_pk((f32x2){v1[0], v1[1]}), d = gelu_pk((f32x2){v1[2], v1[3]});
                        v0 = (f32x4){a.x, a.y, b.x, b.y}; v1 = (f32x4){c.x, c.y, d.x, d.y}; }
                    v0 = v0 * sc; v1 = v1 * sc; u32x4 w; w.x = cvt_pk_bf16(v0[0], v0[1]); w.y = cvt_pk_bf16(v0[2], v0[3]); w.z = cvt_pk_bf16(v1[0], v1[1]); w.w = cvt_pk_bf16(v1[2], v1[3]);
                    *(u32x4*)(rowp + bj * HALF) = w; } }
    }
};

typedef int v8i_t __attribute__((ext_vector_type(8)));
typedef int v4i_t __attribute__((ext_vector_type(4)));
typedef int v2i_t __attribute__((ext_vector_type(2)));
typedef int v6i_t __attribute__((ext_vector_type(6)));
__device__ __forceinline__ v6i_t cat6(v4i_t a, v2i_t b) { v6i_t r; r[0] = a[0]; r[1] = a[1]; r[2] = a[2]; r[3] = a[3]; r[4] = b[0]; r[5] = b[1]; return r; }
__device__ __forceinline__ v8i_t cat8(bf16x8 a, bf16x8 b) { const v4i_t x = __builtin_bit_cast(v4i_t, a), y = __builtin_bit_cast(v4i_t, b); return __builtin_shufflevector(x, y, 0, 1, 2, 3, 4, 5, 6, 7); }
template <class Epi, class Sched, bool ALIGN_EPI = false, bool SP2 = false, bool F8 = false, bool I8 = false, bool F6 = false>
__device__ __forceinline__ void gemm_phase(PG8_LAS unsigned char* lds, const Gemm g, const Sched& S, const Epi& E) {
    int tid_ = threadIdx.x; asm volatile("" : "+v"(tid_));
    const int tid = tid_, wid = __builtin_amdgcn_readfirstlane(tid >> 6), lane = tid & 63, wr = wid >> 2, wc = wid & 3, fr = lane & 15, fq = lane >> 4;
    const int K = g.K, nt = K / BK;
    unsigned voffA[2], voffB[2];
#pragma unroll
    for (int i = 0; i < 2; ++i) { int R, C; stage_rc(tid * 16 + i * 8192, R, C); const int Rb = Epi::PERM ? ((R & ~31) + perm32(R & 31)) : R;
        voffA[i] = (unsigned)(R * g.lda + C) * 2u; voffB[i] = (unsigned)(Rb * g.ldb + C) * 2u; }
    const size_t kstep = (size_t)(BK * 2);
    const size_t hstepA = (size_t)HALF * g.lda * 2, hstepB = (size_t)HALF * g.ldb * 2;
    const size_t tstepA = 2 * hstepA, tstepB = 2 * hstepB;
    const unsigned ldsw = (unsigned)wid * 1024u;
    const int aoff = lds_byte(wr * 64 + fr, fq * 8), boff = lds_byte(wc * 32 + fr, fq * 8);
    const unsigned aaddr = (unsigned)(size_t)lds + (unsigned)aoff, baddr = (unsigned)(size_t)lds + (unsigned)boff + 4u * HTB;
#define PG8_SA(b, h) (((b) * 2 + (h)) * HTB)
#define PG8_SB(b, h) ((4 + (b) * 2 + (h)) * HTB)
#define PG8_STAGE(bufoff, gbase, voff) do { _Pragma("unroll") for (int _i = 0; _i < 2; ++_i) \
        __builtin_amdgcn_global_load_lds((const unsigned*)((const char*)(gbase) + (voff)[_i]), (PG8_LAS unsigned*)(lds + (bufoff) + ldsw + _i * 8192), 16, 0, 0); } while (0)
#define PG8_RD16(d, base, off) asm volatile("ds_read_b128 %0, %1 offset:%2" : "=v"(d) : "v"(base), "i"(off))
#define PG8_RD8(d, base, off) asm volatile("ds_read_b64 %0, %1 offset:%2" : "=v"(d) : "v"(base), "i"(off))
#define PG8_LD6(dst, base, off) do { v4i_t lo_; v2i_t hi_; PG8_RD16(lo_, base, off); PG8_RD8(hi_, base, (off) + 1024); dst = cat6(lo_, hi_); } while (0)
#define PG8_LDA(dst, b, h) do { if constexpr (F6) { PG8_LD6(dst##6[0], aaddr, PG8_SA(b, h)); PG8_LD6(dst##6[1], aaddr, PG8_SA(b, h) + 2048); PG8_LD6(dst##6[2], aaddr, PG8_SA(b, h) + 4096); PG8_LD6(dst##6[3], aaddr, PG8_SA(b, h) + 6144); } else { \
        _Pragma("unroll") for (int m = 0; m < 4; ++m) { if constexpr (F8) { dst##8[m].lo = *(const PG8_LAS v4i_t*)(lds + PG8_SA(b, h) + aoff + m * 2048); dst##8[m].hi = *(const PG8_LAS v4i_t*)(lds + PG8_SA(b, h) + aoff + m * 2048 + 1024); } \
        else { _Pragma("unroll") for (int k = 0; k < 2; ++k) dst[m][k] = *(const PG8_LAS bf16x8*)(lds + PG8_SA(b, h) + aoff + m * 2048 + k * 1024); } } } } while (0)
#define PG8_LDB(dst, b, h) do { if constexpr (F6) { PG8_LD6(dst##6[0], baddr, PG8_SB(b, h) - 4 * HTB); PG8_LD6(dst##6[1], baddr, PG8_SB(b, h) - 4 * HTB + 2048); } else { \
        _Pragma("unroll") for (int n = 0; n < 2; ++n) { if constexpr (F8) { dst##8[n].lo = *(const PG8_LAS v4i_t*)(lds + PG8_SB(b, h) + boff + n * 2048); dst##8[n].hi = *(const PG8_LAS v4i_t*)(lds + PG8_SB(b, h) + boff + n * 2048 + 1024); } \
        else { _Pragma("unroll") for (int k = 0; k < 2; ++k) dst[n][k] = *(const PG8_LAS bf16x8*)(lds + PG8_SB(b, h) + boff + n * 2048 + k * 1024); } } } } while (0)
#define PG8_MMA(ai, bj, At, Bt) do { __builtin_amdgcn_s_setprio(1); \
        if constexpr (F6) { _Pragma("unroll") for (int m = 0; m < 4; ++m) _Pragma("unroll") for (int n = 0; n < 2; ++n) \
            asm volatile("v_mfma_scale_f32_16x16x128_f8f6f4 %0, %1, %2, %0, %3, %3 op_sel_hi:[0,0,0] cbsz:2 blgp:2" : "+v"(acc[ai][bj][m][n]) : "v"(Bt##6[n]), "v"(At##6[m]), "v"(unit_scale)); } \
        else if constexpr (F8) { _Pragma("unroll") for (int m = 0; m < 4; ++m) _Pragma("unroll") for (int n = 0; n < 2; ++n) \
            asm volatile("v_mfma_scale_f32_16x16x128_f8f6f4 %0, %1, %2, %0, %3, %3 op_sel_hi:[0,0,0]" : "+v"(acc[ai][bj][m][n]) : "v"(Bt##8[n]), "v"(At##8[m]), "v"(unit_scale)); } \
        else if constexpr (I8) { _Pragma("unroll") for (int m = 0; m < 4; ++m) _Pragma("unroll") for (int n = 0; n < 2; ++n) _Pragma("unroll") for (int k = 0; k < 2; ++k) \
            acc[ai][bj][m][n] = __builtin_bit_cast(f32x4, __builtin_amdgcn_mfma_i32_16x16x64_i8(__builtin_bit_cast(v4i_t, Bt[n][k]), __builtin_bit_cast(v4i_t, At[m][k]), __builtin_bit_cast(v4i_t, acc[ai][bj][m][n]), 0, 0, 0)); } \
        else { _Pragma("unroll") for (int m = 0; m < 4; ++m) _Pragma("unroll") for (int n = 0; n < 2; ++n) _Pragma("unroll") for (int k = 0; k < 2; ++k) \
            acc[ai][bj][m][n] = __builtin_amdgcn_mfma_f32_16x16x32_bf16(Bt[n][k], At[m][k], acc[ai][bj][m][n], 0, 0, 0); } \
        __builtin_amdgcn_s_setprio(0); } while (0)
#define PG8_WAIT_V(n) asm volatile("s_waitcnt vmcnt(" #n ")" ::: "memory")
#define PG8_WAIT_L(n) asm volatile("s_waitcnt lgkmcnt(" #n ")" ::: "memory")
#define PG8_BAR __builtin_amdgcn_s_barrier()
#define PG8_SCHED __builtin_amdgcn_sched_barrier(0)
    Unit cur, nxt; int ui = 0;
    if (!S.next(0, cur)) return;
    f32x4 acc[2][2][4][2];
#pragma unroll
    for (int a = 0; a < 2; ++a)
#pragma unroll
        for (int b = 0; b < 2; ++b)
#pragma unroll
            for (int m = 0; m < 4; ++m)
#pragma unroll
                for (int n = 0; n < 2; ++n) acc[a][b][m][n] = (f32x4){0.f, 0.f, 0.f, 0.f};
    bf16x8 At[4][2], B0[2][2], B1[2][2];
    const int unit_scale = 0x7f7f7f7f;
    v6i_t At6[4], B06[2], B16[2];
    v8i_t At8[4], B08[2], B18[2];
    const char* cA = (const char*)g.A + (size_t)cur.pm * tstepA; const char* cB = (const char*)g.Bt + (size_t)cur.pn * tstepB;
    S.a_ready(cur);
    if constexpr (SP2) {
        PG8_STAGE(PG8_SB(0, 0), cB, voffB); PG8_STAGE(PG8_SB(0, 1), cB + hstepB, voffB); PG8_STAGE(PG8_SA(0, 0), cA, voffA); PG8_STAGE(PG8_SA(0, 1), cA + hstepA, voffA);
        if (wr == 1) PG8_BAR;
        PG8_WAIT_V(2); PG8_BAR;
        PG8_STAGE(PG8_SB(1, 0), cB + kstep, voffB); PG8_STAGE(PG8_SA(1, 0), cA + kstep, voffA); PG8_STAGE(PG8_SB(1, 1), cB + hstepB + kstep, voffB);
        PG8_WAIT_V(6); PG8_BAR;
    } else {
        PG8_STAGE(PG8_SB(0, 0), cB, voffB); PG8_STAGE(PG8_SA(0, 0), cA, voffA); PG8_STAGE(PG8_SB(0, 1), cB + hstepB, voffB); PG8_STAGE(PG8_SA(0, 1), cA + hstepA, voffA);
        if (wr == 1) PG8_BAR;
        PG8_WAIT_V(4); PG8_BAR;
        PG8_STAGE(PG8_SB(1, 0), cB + kstep, voffB); PG8_STAGE(PG8_SA(1, 0), cA + kstep, voffA); PG8_STAGE(PG8_SB(1, 1), cB + hstepB + kstep, voffB);
        PG8_WAIT_V(6); PG8_BAR;
    }
    for (;;) {
        const bool has_next = S.next(ui + 1, nxt);
        const char* nA = has_next ? (const char*)g.A + (size_t)nxt.pm * tstepA : cA; const char* nB = has_next ? (const char*)g.Bt + (size_t)nxt.pn * tstepB : cB;
        for (int t = 0; t < nt; t += 2) {
            const bool last = (t == nt - 2);
            const char* a1 = cA + (size_t)(t + 1) * kstep;
            const char* a2 = last ? nA : cA + (size_t)(t + 2) * kstep; const char* b2 = last ? nB : cB + (size_t)(t + 2) * kstep;
            const char* a3 = a2 + kstep; const char* b3 = b2 + kstep;
            if (last && has_next) S.a_ready(nxt);
            if constexpr (SP2) {
            PG8_LDB(B0, 0, 0); PG8_LDB(B1, 0, 1); PG8_SCHED; PG8_LDA(At, 0, 0); PG8_STAGE(PG8_SA(1, 1), a1 + hstepA, voffA);
            PG8_WAIT_V(8); PG8_WAIT_L(0); PG8_BAR; PG8_MMA(0, 0, At, B0); PG8_MMA(0, 1, At, B1); PG8_BAR; PG8_SCHED;
            PG8_LDA(At, 0, 1); PG8_STAGE(PG8_SB(0, 0), b2, voffB); PG8_STAGE(PG8_SB(0, 1), b2 + hstepB, voffB); PG8_STAGE(PG8_SA(0, 0), a2, voffA);
            PG8_WAIT_V(8); PG8_WAIT_L(0); PG8_BAR; PG8_MMA(1, 0, At, B0); PG8_MMA(1, 1, At, B1); PG8_BAR; PG8_SCHED;
            PG8_LDB(B0, 1, 0); PG8_LDB(B1, 1, 1); PG8_SCHED; PG8_LDA(At, 1, 0); PG8_STAGE(PG8_SA(0, 1), a2 + hstepA, voffA);
            PG8_WAIT_V(8); PG8_WAIT_L(0); PG8_BAR; PG8_MMA(0, 0, At, B0); PG8_MMA(0, 1, At, B1); PG8_BAR; PG8_SCHED;
            PG8_LDA(At, 1, 1); PG8_STAGE(PG8_SB(1, 0), b3, voffB); PG8_STAGE(PG8_SB(1, 1), b3 + hstepB, voffB); PG8_STAGE(PG8_SA(1, 0), a3, voffA);
            PG8_WAIT_V(8); PG8_WAIT_L(0); PG8_BAR; PG8_MMA(1, 0, At, B0); PG8_MMA(1, 1, At, B1); PG8_BAR; PG8_SCHED;
            } else {
            PG8_LDB(B0, 0, 0); PG8_SCHED; PG8_LDA(At, 0, 0); PG8_STAGE(PG8_SA(1, 1), a1 + hstepA, voffA);
            PG8_WAIT_L(8); PG8_BAR; PG8_WAIT_L(0); PG8_MMA(0, 0, At, B0); PG8_BAR; PG8_SCHED;
            PG8_LDB(B1, 0, 1); PG8_STAGE(PG8_SB(0, 0), b2, voffB);
            PG8_BAR; PG8_WAIT_L(0); PG8_MMA(0, 1, At, B1); PG8_BAR;
            PG8_LDA(At, 0, 1); PG8_STAGE(PG8_SA(0, 0), a2, voffA);
            PG8_BAR; PG8_WAIT_L(0); PG8_MMA(1, 0, At, B0); PG8_BAR; PG8_SCHED;
            PG8_STAGE(PG8_SB(0, 1), b2 + hstepB, voffB);
            PG8_WAIT_V(6); PG8_BAR; PG8_MMA(1, 1, At, B1); PG8_BAR;
            PG8_LDB(B0, 1, 0); PG8_SCHED; PG8_LDA(At, 1, 0); PG8_STAGE(PG8_SA(0, 1), a2 + hstepA, voffA);
            PG8_WAIT_L(8); PG8_BAR; PG8_WAIT_L(0); PG8_MMA(0, 0, At, B0); PG8_BAR; PG8_SCHED;
            PG8_LDB(B1, 1, 1); PG8_STAGE(PG8_SB(1, 0), b3, voffB);
            PG8_BAR; PG8_WAIT_L(0); PG8_MMA(0, 1, At, B1); PG8_BAR;
            PG8_LDA(At, 1, 1); PG8_STAGE(PG8_SA(1, 0), a3, voffA);
            PG8_BAR; PG8_WAIT_L(0); PG8_MMA(1, 0, At, B0); PG8_BAR; PG8_SCHED;
            PG8_STAGE(PG8_SB(1, 1), b3 + hstepB, voffB);
            PG8_WAIT_V(6); PG8_BAR; PG8_MMA(1, 1, At, B1); PG8_BAR;
            }
        }
        if constexpr (F8 || F6) asm volatile("s_nop 15\n\ts_nop 15" ::: "memory");
        if constexpr (ALIGN_EPI) { if (wr == 0) PG8_BAR; }
        if constexpr (!Epi::AFTER_DRAIN) { E(acc, cur, wr, wc, fr, fq); S.done(cur); }
        if (!has_next) break;
#pragma unroll
        for (int a = 0; a < 2; ++a)
#pragma unroll
            for (int b = 0; b < 2; ++b)
#pragma unroll
                for (int m = 0; m < 4; ++m)
#pragma unroll
                    for (int n = 0; n < 2; ++n) acc[a][b][m][n] = (f32x4){0.f, 0.f, 0.f, 0.f};
        cur = nxt; cA = nA; cB = nB; ++ui;
        if constexpr (ALIGN_EPI) { if (wr == 1) PG8_BAR; }
    }
    PG8_WAIT_V(0);
    if constexpr (!ALIGN_EPI) { if (wr == 0) PG8_BAR; }
    PG8_BAR;
    if constexpr (Epi::AFTER_DRAIN) { E.fused(acc, cur, wr, wc, fr, fq, lds, wid, lane); S.done(cur); }
#undef PG8_SA
#undef PG8_SB
#undef PG8_STAGE
#undef PG8_LDA
#undef PG8_RD16
#undef PG8_RD8
#undef PG8_LD6
#undef PG8_LDB
#undef PG8_MMA
#undef PG8_WAIT_V
#undef PG8_WAIT_L
#undef PG8_BAR
#undef PG8_SCHED
}
}

namespace pg8 {
template <int CTRL> __device__ __forceinline__ float dpp_f(float x) { return __builtin_bit_cast(float, __builtin_amdgcn_mov_dpp(__builtin_bit_cast(int, x), CTRL, 0xf, 0xf, true)); }
__device__ __forceinline__ float row16_sum(float x) { x += dpp_f<0xB1>(x); x += dpp_f<0x4E>(x); x += dpp_f<0x141>(x); x += dpp_f<0x128>(x); return x; }
__device__ __forceinline__ float fq4_sum(float x) {
    const auto s = __builtin_amdgcn_permlane16_swap(__float_as_uint(x), __float_as_uint(x), false, false); x = __uint_as_float(s[0]) + __uint_as_float(s[1]);
    const auto t = __builtin_amdgcn_permlane32_swap(__float_as_uint(x), __float_as_uint(x), false, false); return __uint_as_float(t[0]) + __uint_as_float(t[1]); }
__device__ __forceinline__ float fq4_max(float x) {
    const auto s = __builtin_amdgcn_permlane16_swap(__float_as_uint(x), __float_as_uint(x), false, false); x = fmaxf(__uint_as_float(s[0]), __uint_as_float(s[1]));
    const auto t = __builtin_amdgcn_permlane32_swap(__float_as_uint(x), __float_as_uint(x), false, false); return fmaxf(__uint_as_float(t[0]), __uint_as_float(t[1])); }
struct EpiF32Res {
    static constexpr bool PERM = false, AFTER_DRAIN = false;
    const float* base; float* out; int ldc; float scl;
    __device__ __forceinline__ void operator()(const f32x4 (&acc)[2][2][4][2], const Unit& u, int wr, int wc, int fr, int fq) const {
        const int row0 = u.pm * BM + wr * 64 + fr, col0 = u.pn * BM + wc * 32 + 4 * fq;
#pragma unroll
        for (int ai = 0; ai < 2; ++ai) {
            f32x4 bs[4][2][2];
#pragma unroll
            for (int m = 0; m < 4; ++m) { const size_t off = (size_t)(row0 + ai * HALF + m * 16) * ldc + col0;
#pragma unroll
                for (int bj = 0; bj < 2; ++bj)
#pragma unroll
                    for (int n = 0; n < 2; ++n) bs[m][bj][n] = *(const f32x4*)(base + off + bj * HALF + n * 16); }
#pragma unroll
            for (int m = 0; m < 4; ++m) { const size_t off = (size_t)(row0 + ai * HALF + m * 16) * ldc + col0;
#pragma unroll
                for (int bj = 0; bj < 2; ++bj)
#pragma unroll
                    for (int n = 0; n < 2; ++n) *(f32x4*)(out + off + bj * HALF + n * 16) = bs[m][bj][n] + acc[ai][bj][m][n] * scl; }
        }
    }
};
struct EpiGate {
    static constexpr bool PERM = true, AFTER_DRAIN = false;
    bf16_t* G; int ldc;
    __device__ __forceinline__ void operator()(const f32x4 (&acc)[2][2][4][2], const Unit& u, int wr, int wc, int fr, int fq) const {
        const int row0 = u.pm * BM + wr * 64 + fr, col0 = u.pn * BM + wc * 32 + 8 * fq;
#pragma unroll
        for (int ai = 0; ai < 2; ++ai)
#pragma unroll
            for (int m = 0; m < 4; ++m) { bf16_t* rowp = G + (size_t)(row0 + ai * HALF + m * 16) * ldc + col0;
#pragma unroll
                for (int bj = 0; bj < 2; ++bj) { const u32x4 g = *(const u32x4*)(rowp + bj * HALF);
                    if ((g.x | g.y | g.z | g.w) != 0u) {
                        const f32x4 v0 = acc[ai][bj][m][0], v1 = acc[ai][bj][m][1];
                        const f32x2 a = gelu_pk((f32x2){v0[0], v0[1]}), b = gelu_pk((f32x2){v0[2], v0[3]}), c = gelu_pk((f32x2){v1[0], v1[1]}), d = gelu_pk((f32x2){v1[2], v1[3]});
                        u32x4 w;
                        w.x = cvt_pk_bf16(a.x * __uint_as_float(g.x << 16), a.y * __uint_as_float(g.x & 0xffff0000u));
                        w.y = cvt_pk_bf16(b.x * __uint_as_float(g.y << 16), b.y * __uint_as_float(g.y & 0xffff0000u));
                        w.z = cvt_pk_bf16(c.x * __uint_as_float(g.z << 16), c.y * __uint_as_float(g.z & 0xffff0000u));
                        w.w = cvt_pk_bf16(d.x * __uint_as_float(g.w << 16), d.y * __uint_as_float(g.w & 0xffff0000u));
                        *(u32x4*)(rowp + bj * HALF) = w; } } }
    }
};
template <bool BASE16, bool WITH_F8, bool ACC_I8 = false, bool WITH_I8 = false> struct EpiResNorm {
    static constexpr bool PERM = false, AFTER_DRAIN = false;
    const void* base; int ldbase; bf16_t* X16; int ld16; unsigned char* X8; int ld8; unsigned long long* rowss; float scl;
    unsigned* rowmax;
    unsigned char* X8i; int ld8i; const unsigned* qmax;
    const float* sa; const unsigned* sbmax;
    __device__ __forceinline__ void operator()(const f32x4 (&acc)[2][2][4][2], const Unit& u, int wr, int wc, int fr, int fq) const {
        typedef unsigned u32x2 __attribute__((ext_vector_type(2)));
        const int row0 = u.pm * BM + wr * 64 + fr, col0 = u.pn * BM + wc * 32 + 4 * fq;
#pragma unroll
        for (int ai = 0; ai < 2; ++ai) {
            f32x4 bs[4][2][2];
#pragma unroll
            for (int m = 0; m < 4; ++m) { const size_t off = (size_t)(row0 + ai * HALF + m * 16) * ldbase + col0;
#pragma unroll
                for (int bj = 0; bj < 2; ++bj)
#pragma unroll
                    for (int n = 0; n < 2; ++n) {
                        if constexpr (BASE16) { const u32x2 w = *(const u32x2*)((const bf16_t*)base + off + bj * HALF + n * 16);
                            bs[m][bj][n] = (f32x4){__uint_as_float(w.x << 16), __uint_as_float(w.x & 0xffff0000u), __uint_as_float(w.y << 16), __uint_as_float(w.y & 0xffff0000u)}; }
                        else bs[m][bj][n] = *(const f32x4*)((const float*)base + off + bj * HALF + n * 16); } }
#pragma unroll
            for (int m = 0; m < 4; ++m) { const int row = row0 + ai * HALF + m * 16; const size_t off = (size_t)row * ld16 + col0, off8 = (size_t)row * ld8 + col0; float ss = 0.f, mx = 0.f;
                float qinv = 0.f; if constexpr (WITH_I8) { const float qm = __uint_as_float(qmax[row]); qinv = qm > 0.f ? 127.f / (1.25f * qm) : 0.f; }
#pragma unroll
                for (int bj = 0; bj < 2; ++bj)
#pragma unroll
                    for (int n = 0; n < 2; ++n) { f32x4 a_ = acc[ai][bj][m][n];
                        if constexpr (ACC_I8) { const v4i_t ai_ = __builtin_bit_cast(v4i_t, a_); const u32x4 sm = *(const u32x4*)(sbmax + (col0 + bj * HALF + n * 16));
                            const float sr = sa[row] * (1.f / 127.f);
                            a_ = (f32x4){(float)ai_[0] * (sr * __uint_as_float(sm.x)), (float)ai_[1] * (sr * __uint_as_float(sm.y)), (float)ai_[2] * (sr * __uint_as_float(sm.z)), (float)ai_[3] * (sr * __uint_as_float(sm.w))}; }
                        const f32x4 v = bs[m][bj][n] + a_ * scl;
                        ss += (v[0] * v[0] + v[1] * v[1]) + (v[2] * v[2] + v[3] * v[3]);
                        mx = fmaxf(fmaxf(mx, fmaxf(fabsf(v[0]), fabsf(v[1]))), fmaxf(fabsf(v[2]), fabsf(v[3])));
                        if constexpr (WITH_I8) { unsigned q = 0u; q = __builtin_amdgcn_cvt_pk_u8_f32(rintf(v[0] * qinv) + 128.f, 0, q); q = __builtin_amdgcn_cvt_pk_u8_f32(rintf(v[1] * qinv) + 128.f, 1, q); q = __builtin_amdgcn_cvt_pk_u8_f32(rintf(v[2] * qinv) + 128.f, 2, q); q = __builtin_amdgcn_cvt_pk_u8_f32(rintf(v[3] * qinv) + 128.f, 3, q);
                            *(unsigned*)(X8i + (size_t)row * ld8i + col0 + bj * HALF + n * 16) = q ^ 0x80808080u; }
                        u32x2 w; w.x = cvt_pk_bf16(v[0], v[1]); w.y = cvt_pk_bf16(v[2], v[3]); *(u32x2*)(X16 + off + bj * HALF + n * 16) = w;
                        if constexpr (WITH_F8) { int t = 0; t = __builtin_amdgcn_cvt_pk_fp8_f32(v[0], v[1], t, false); t = __builtin_amdgcn_cvt_pk_fp8_f32(v[2], v[3], t, true); *(unsigned*)(X8 + off8 + bj * HALF + n * 16) = (unsigned)t; } }
                ss = fq4_sum(ss);
                if (rowmax) { mx = fq4_max(mx); }
                if (fq == 0) { atomicAdd(rowss + row, (unsigned long long)(ss * 16777216.f + 0.5f)); if (rowmax) atomicMax(rowmax + row, __float_as_uint(mx)); } }
        }
    }
};
struct EpiResNormF6 {
    static constexpr bool PERM = false, AFTER_DRAIN = false;
    const bf16_t* base; int ldbase; bf16_t* X16; int ld16; unsigned char* X6; int ld6; unsigned long long* rowss; unsigned char* X8i; int ld8i; const unsigned* qmax;
    __device__ __forceinline__ void operator()(const f32x4 (&acc)[2][2][4][2], const Unit& u, int wr, int wc, int fr, int fq) const {
        typedef unsigned u32x2 __attribute__((ext_vector_type(2)));
        typedef float v16f_t __attribute__((ext_vector_type(16)));
        typedef unsigned v6u_t __attribute__((ext_vector_type(6)));
        const int row0 = u.pm * BM + wr * 64 + fr, col0 = u.pn * BM + wc * 32 + 4 * fq;
        const int g6off = (u.pn * 2 + (wc >> 1)) * 128 + ((wc & 1) * 2 + (fq >> 1)) * 16;
        float qmv[2][4];
#pragma unroll
        for (int ai = 0; ai < 2; ++ai)
#pragma unroll
            for (int m = 0; m < 4; ++m) qmv[ai][m] = __uint_as_float(qmax[row0 + ai * HALF + m * 16]);
#pragma unroll
        for (int ai = 0; ai < 2; ++ai)
#pragma unroll
            for (int mp = 0; mp < 2; ++mp) {
                u32x2 bs[2][2][2];
#pragma unroll
                for (int mm = 0; mm < 2; ++mm) { const size_t off = (size_t)(row0 + ai * HALF + (2 * mp + mm) * 16) * ldbase + col0;
#pragma unroll
                    for (int bj = 0; bj < 2; ++bj)
#pragma unroll
                        for (int n = 0; n < 2; ++n) bs[mm][bj][n] = *(const u32x2*)(base + off + bj * HALF + n * 16); }
                v16f_t V[2];
#pragma unroll
                for (int mm = 0; mm < 2; ++mm) { const int m = 2 * mp + mm, row = row0 + ai * HALF + m * 16; const size_t off = (size_t)row * ld16 + col0; float ss = 0.f;
                    const float qm = qmv[ai][m]; const float qinv = qm > 0.f ? 127.f / (1.25f * qm) : 0.f, finv = qm > 0.f ? 7.5f / (1.25f * qm) : 0.f;
#pragma unroll
                    for (int bj = 0; bj < 2; ++bj)
#pragma unroll
                        for (int n = 0; n < 2; ++n) { const u32x2 w0 = bs[mm][bj][n];
                            const f32x4 v = (f32x4){__uint_as_float(w0.x << 16), __uint_as_float(w0.x & 0xffff0000u), __uint_as_float(w0.y << 16), __uint_as_float(w0.y & 0xffff0000u)} + acc[ai][bj][m][n];
                            ss += (v[0] * v[0] + v[1] * v[1]) + (v[2] * v[2] + v[3] * v[3]);
                            { unsigned q = 0u; q = __builtin_amdgcn_cvt_pk_u8_f32(rintf(v[0] * qinv) + 128.f, 0, q); q = __builtin_amdgcn_cvt_pk_u8_f32(rintf(v[1] * qinv) + 128.f, 1, q); q = __builtin_amdgcn_cvt_pk_u8_f32(rintf(v[2] * qinv) + 128.f, 2, q); q = __builtin_amdgcn_cvt_pk_u8_f32(rintf(v[3] * qinv) + 128.f, 3, q);
                              *(unsigned*)(X8i + (size_t)row * ld8i + col0 + bj * HALF + n * 16) = q ^ 0x80808080u; }
                            u32x2 w; w.x = cvt_pk_bf16(v[0], v[1]); w.y = cvt_pk_bf16(v[2], v[3]); *(u32x2*)(X16 + off + bj * HALF + n * 16) = w;
#pragma unroll
                            for (int j = 0; j < 4; ++j) V[mm][(bj * 2 + n) * 4 + j] = __builtin_amdgcn_fmed3f(v[j] * finv, -7.5f, 7.5f); }
                    ss = fq4_sum(ss);
                    if (fq == 0) atomicAdd(rowss + row, (unsigned long long)(ss * 16777216.f + 0.5f)); }
#pragma unroll
                for (int i = 0; i < 16; ++i) { const auto r = __builtin_amdgcn_permlane16_swap(__float_as_uint(V[0][i]), __float_as_uint(V[1][i]), false, false); V[0][i] = __uint_as_float(r[0]); V[1][i] = __uint_as_float(r[1]); }
                const v6u_t o = __builtin_amdgcn_cvt_scalef32_2xpk16_fp6_f32(V[0], V[1], 1.0f);
                unsigned char* dp = X6 + (size_t)(row0 + ai * HALF + (2 * mp + (fq & 1)) * 16) * ld6 + g6off;
                *(u32x4*)dp = (u32x4){o[0], o[1], o[2], o[3]}; *(u32x2*)(dp + 64) = (u32x2){o[4], o[5]};
            }
    }
};
struct EpiF32ResB16 {
    static constexpr bool PERM = false, AFTER_DRAIN = false;
    const bf16_t* base; int ldbase; float* out; int ldc; float scl;
    __device__ __forceinline__ void operator()(const f32x4 (&acc)[2][2][4][2], const Unit& u, int wr, int wc, int fr, int fq) const {
        typedef unsigned u32x2 __attribute__((ext_vector_type(2)));
        const int row0 = u.pm * BM + wr * 64 + fr, col0 = u.pn * BM + wc * 32 + 4 * fq;
        u32x2 bs[2][4][2][2];
#pragma unroll
        for (int ai = 0; ai < 2; ++ai)
#pragma unroll
            for (int m = 0; m < 4; ++m) { const size_t off = (size_t)(row0 + ai * HALF + m * 16) * ldbase + col0;
#pragma unroll
                for (int bj = 0; bj < 2; ++bj)
#pragma unroll
                    for (int n = 0; n < 2; ++n) bs[ai][m][bj][n] = *(const u32x2*)(base + off + bj * HALF + n * 16); }
#pragma unroll
        for (int ai = 0; ai < 2; ++ai)
#pragma unroll
            for (int m = 0; m < 4; ++m) { const size_t off = (size_t)(row0 + ai * HALF + m * 16) * ldc + col0;
#pragma unroll
                for (int bj = 0; bj < 2; ++bj)
#pragma unroll
                    for (int n = 0; n < 2; ++n) { const u32x2 w = bs[ai][m][bj][n];
                        const f32x4 b = {__uint_as_float(w.x << 16), __uint_as_float(w.x & 0xffff0000u), __uint_as_float(w.y << 16), __uint_as_float(w.y & 0xffff0000u)};
                        *(f32x4*)(out + off + bj * HALF + n * 16) = b + acc[ai][bj][m][n] * scl; } }
    }
};
struct EpiBf16Row {
    static constexpr bool PERM = true, AFTER_DRAIN = false;
    bf16_t* O; int ldc; const unsigned long long* rowss; float inv_n, eps;
    __device__ __forceinline__ void operator()(const f32x4 (&acc)[2][2][4][2], const Unit& u, int wr, int wc, int fr, int fq) const {
        const int row0 = u.pm * BM + wr * 64 + fr, col0 = u.pn * BM + wc * 32 + 8 * fq;
        float rv[2][4];
#pragma unroll
        for (int ai = 0; ai < 2; ++ai)
#pragma unroll
            for (int m = 0; m < 4; ++m) rv[ai][m] = 1.0f / sqrtf((float)rowss[row0 + ai * HALF + m * 16] * inv_n + eps);
#pragma unroll
        for (int ai = 0; ai < 2; ++ai)
#pragma unroll
            for (int m = 0; m < 4; ++m) { const int row = row0 + ai * HALF + m * 16; bf16_t* rowp = O + (size_t)row * ldc + col0;
                const float r = rv[ai][m];
#pragma unroll
                for (int bj = 0; bj < 2; ++bj) { const f32x4 v0 = acc[ai][bj][m][0] * r, v1 = acc[ai][bj][m][1] * r;
                    u32x4 w; w.x = cvt_pk_bf16(v0[0], v0[1]); w.y = cvt_pk_bf16(v0[2], v0[3]); w.z = cvt_pk_bf16(v1[0], v1[1]); w.w = cvt_pk_bf16(v1[2], v1[3]);
                    *(u32x4*)(rowp + bj * HALF) = w; } }
    }
};
struct EpiBf16RowI8 {
    static constexpr bool PERM = true, AFTER_DRAIN = false;
    bf16_t* O; int ldc; const unsigned long long* rowss; float inv_n, eps; const unsigned* qmax; const unsigned* cmax;
    __device__ __forceinline__ void operator()(const f32x4 (&acc)[2][2][4][2], const Unit& u, int wr, int wc, int fr, int fq) const {
        const int row0 = u.pm * BM + wr * 64 + fr, col0 = u.pn * BM + wc * 32 + 8 * fq;
        f32x4 sb[2][2];
#pragma unroll
        for (int bj = 0; bj < 2; ++bj)
#pragma unroll
            for (int n = 0; n < 2; ++n) { const u32x4 cm = *(const u32x4*)(cmax + col0 + bj * HALF + 4 * n); sb[bj][n] = (f32x4){__uint_as_float(cm.x), __uint_as_float(cm.y), __uint_as_float(cm.z), __uint_as_float(cm.w)} * (1.f / 127.f); }
        float rv[2][4];
#pragma unroll
        for (int ai = 0; ai < 2; ++ai)
#pragma unroll
            for (int m = 0; m < 4; ++m) { const int row = row0 + ai * HALF + m * 16; rv[ai][m] = (1.25f / 127.f) * __uint_as_float(qmax[row]) / sqrtf((float)rowss[row] * inv_n + eps); }
#pragma unroll
        for (int ai = 0; ai < 2; ++ai)
#pragma unroll
            for (int m = 0; m < 4; ++m) { const int row = row0 + ai * HALF + m * 16; bf16_t* rowp = O + (size_t)row * ldc + col0;
                const float r = rv[ai][m];
#pragma unroll
                for (int bj = 0; bj < 2; ++bj) { const v4i_t i0 = __builtin_bit_cast(v4i_t, acc[ai][bj][m][0]), i1 = __builtin_bit_cast(v4i_t, acc[ai][bj][m][1]);
                    const f32x4 v0 = (f32x4){(float)i0[0], (float)i0[1], (float)i0[2], (float)i0[3]} * sb[bj][0] * r, v1 = (f32x4){(float)i1[0], (float)i1[1], (float)i1[2], (float)i1[3]} * sb[bj][1] * r;
                    u32x4 w; w.x = cvt_pk_bf16(v0[0], v0[1]); w.y = cvt_pk_bf16(v0[2], v0[3]); w.z = cvt_pk_bf16(v1[0], v1[1]); w.w = cvt_pk_bf16(v1[2], v1[3]);
                    *(u32x4*)(rowp + bj * HALF) = w; } }
    }
};
struct EpiProj {
    static constexpr bool PERM = true, AFTER_DRAIN = false;
    bf16_t* O; int ldc; const float* gq; const float* gk; bf16_t* KMEAN; PG8_LAS float* X; float eps; int pn_skip;
    const float* sa; const unsigned* cmax;
    __device__ __forceinline__ void operator()(const f32x4 (&acc)[2][2][4][2], const Unit& u, int wr, int wc, int fr_, int fq_) const {
        int fr = fr_, fq = fq_; asm volatile("" : "+v"(fr), "+v"(fq));
        const int pcol = u.pn < 16 ? u.pn : u.pn + pn_skip;
        const int row0 = u.pm * BM + wr * 64 + fr;
        bf16_t* const hb0 = O + ((size_t)(((pcol >> 3) * 64 + (u.pm >> 4) * 16 + (pcol & 7) * 2) * 4096 + (u.pm & 15) * 256 + wr * 64 + fr)) * 128 + wc * 32 + 8 * fq;
        constexpr size_t HSTEP = (size_t)4096 * 128;
        if (sa) {
            f32x4 (&A)[2][2][4][2] = const_cast<f32x4 (&)[2][2][4][2]>(acc);
            const int n0 = u.pn * BM + wc * 32 + 8 * fq;
#pragma unroll
            for (int bj = 0; bj < 2; ++bj)
#pragma unroll
                for (int n = 0; n < 2; ++n) { const u32x4 cm = *(const u32x4*)(cmax + n0 + bj * HALF + 4 * n);
                    const f32x4 sb = (f32x4){__uint_as_float(cm.x), __uint_as_float(cm.y), __uint_as_float(cm.z), __uint_as_float(cm.w)} * (1.f / 127.f);
#pragma unroll
                    for (int ai = 0; ai < 2; ++ai)
#pragma unroll
                        for (int m = 0; m < 4; ++m) { const v4i_t iv = __builtin_bit_cast(v4i_t, A[ai][bj][m][n]); const float sr = sa[row0 + ai * HALF + m * 16];
                            A[ai][bj][m][n] = (f32x4){(float)iv[0], (float)iv[1], (float)iv[2], (float)iv[3]} * sb * sr; } }
        }
        if (u.pn >= 16) {
#pragma unroll
            for (int ai = 0; ai < 2; ++ai)
#pragma unroll
                for (int m = 0; m < 4; ++m) { bf16_t* rowp = hb0 + (size_t)(ai * HALF + m * 16) * 128;
#pragma unroll
                    for (int bj = 0; bj < 2; ++bj) { const f32x4 v0 = acc[ai][bj][m][0], v1 = acc[ai][bj][m][1];
                        u32x4 w; w.x = cvt_pk_bf16(v0[0], v0[1]); w.y = cvt_pk_bf16(v0[2], v0[3]); w.z = cvt_pk_bf16(v1[0], v1[1]); w.w = cvt_pk_bf16(v1[2], v1[3]);
                        *(u32x4*)(rowp + bj * HSTEP) = w; } }
            return;
        }
        const bool isk = u.pn >= 8;
#pragma unroll
        for (int ai = 0; ai < 2; ++ai)
#pragma unroll
            for (int m = 0; m < 4; ++m)
#pragma unroll
                for (int bj = 0; bj < 2; ++bj) { const f32x4 a = acc[ai][bj][m][0], b = acc[ai][bj][m][1];
                    float ss = ((a[0] * a[0] + a[1] * a[1]) + (a[2] * a[2] + a[3] * a[3])) + ((b[0] * b[0] + b[1] * b[1]) + (b[2] * b[2] + b[3] * b[3]));
                    ss = fq4_sum(ss);
                    if (fq == 0) X[((ai * HALF + wr * 64 + m * 16 + fr) * 2 + bj) * 4 + wc] = ss; __builtin_amdgcn_sched_barrier(0); }
        asm volatile("s_waitcnt lgkmcnt(0)" ::: "memory"); __builtin_amdgcn_s_barrier(); asm volatile("" ::: "memory");
        const float* g = isk ? gk : gq;
        const f32x4 ga = *(const f32x4*)(g + wc * 32 + 8 * fq), gb = *(const f32x4*)(g + wc * 32 + 8 * fq + 4);
        f32x4 cs[2][2];
#pragma unroll
        for (int bj = 0; bj < 2; ++bj) { cs[bj][0] = (f32x4){0.f, 0.f, 0.f, 0.f}; cs[bj][1] = (f32x4){0.f, 0.f, 0.f, 0.f}; }
#pragma unroll
        for (int ai = 0; ai < 2; ++ai)
#pragma unroll
            for (int m = 0; m < 4; ++m) { const int rowl = ai * HALF + wr * 64 + m * 16 + fr; bf16_t* rowp = hb0 + (size_t)(ai * HALF + m * 16) * 128;
#pragma unroll
                for (int bj = 0; bj < 2; ++bj) { const f32x4 p = *(const PG8_LAS f32x4*)(X + (rowl * 2 + bj) * 4);
                    const float r = 1.0f / sqrtf(((p[0] + p[1]) + (p[2] + p[3])) * (1.f / 128.f) + eps);
                    const f32x4 v0 = acc[ai][bj][m][0] * r * ga, v1 = acc[ai][bj][m][1] * r * gb;
                    cs[bj][0] += v0; cs[bj][1] += v1; asm volatile("" : "+v"(cs[bj][0]), "+v"(cs[bj][1]));
                    u32x4 w; w.x = cvt_pk_bf16(v0[0], v0[1]); w.y = cvt_pk_bf16(v0[2], v0[3]); w.z = cvt_pk_bf16(v1[0], v1[1]); w.w = cvt_pk_bf16(v1[2], v1[3]);
                    *(u32x4*)(rowp + bj * HSTEP) = w; __builtin_amdgcn_sched_barrier(0); } }
        if (isk) {
            PG8_LAS float* C = X + 2048;
#pragma unroll
            for (int bj = 0; bj < 2; ++bj)
#pragma unroll
                for (int n = 0; n < 2; ++n)
#pragma unroll
                    for (int j = 0; j < 4; ++j) { float s = cs[bj][n][j];
                        s = row16_sum(s);
                        if (fr == 0) C[(wr * 2 + bj) * 128 + wc * 32 + 8 * fq + 4 * n + j] = s; __builtin_amdgcn_sched_barrier(0); }
            asm volatile("s_waitcnt lgkmcnt(0)" ::: "memory"); __builtin_amdgcn_s_barrier(); asm volatile("" ::: "memory");
            const int t = (wr * 4 + wc) * 64 + fq * 16 + fr;
            if (t < 256) { const int bj = t >> 7, ch = t & 127; const float s = C[(0 * 2 + bj) * 128 + ch] + C[(1 * 2 + bj) * 128 + ch];
                const int hh = (u.pn - 8) * 2 + bj, bb = u.pm >> 4, blk = u.pm & 15;
                const unsigned q = __float_as_uint(s * (1.f / 256.f)); KMEAN[((size_t)((bb * 16 + hh) * 16 + blk)) * 128 + ch] = (bf16_t)((q + 0x7fffu + ((q >> 16) & 1u)) >> 16); }
        }
    }
};
struct EpiBf16MapI8 {
    static constexpr bool PERM = true, AFTER_DRAIN = false;
    bf16_t* O; int ldc; int pn0, pn1; const float* sa; const unsigned* cmax;
    __device__ __forceinline__ void operator()(const f32x4 (&acc)[2][2][4][2], const Unit& u, int wr, int wc, int fr, int fq) const {
        const int pcol = u.pn < 8 ? pn0 + u.pn : pn1 + u.pn - 8;
        const int row0 = u.pm * BM + wr * 64 + fr, col0 = pcol * BM + wc * 32 + 8 * fq, n0 = u.pn * BM + wc * 32 + 8 * fq;
        f32x4 sb[2][2];
#pragma unroll
        for (int bj = 0; bj < 2; ++bj)
#pragma unroll
            for (int n = 0; n < 2; ++n) { const u32x4 cm = *(const u32x4*)(cmax + n0 + bj * HALF + 4 * n); sb[bj][n] = (f32x4){__uint_as_float(cm.x), __uint_as_float(cm.y), __uint_as_float(cm.z), __uint_as_float(cm.w)} * (1.f / 127.f); }
#pragma unroll
        for (int ai = 0; ai < 2; ++ai)
#pragma unroll
            for (int m = 0; m < 4; ++m) { const int row = row0 + ai * HALF + m * 16; bf16_t* rowp = O + (size_t)row * ldc + col0; const float sr = sa[row];
#pragma unroll
                for (int bj = 0; bj < 2; ++bj) { const v4i_t i0 = __builtin_bit_cast(v4i_t, acc[ai][bj][m][0]), i1 = __builtin_bit_cast(v4i_t, acc[ai][bj][m][1]);
                    const f32x4 v0 = (f32x4){(float)i0[0], (float)i0[1], (float)i0[2], (float)i0[3]} * sb[bj][0] * sr, v1 = (f32x4){(float)i1[0], (float)i1[1], (float)i1[2], (float)i1[3]} * sb[bj][1] * sr;
                    u32x4 w; w.x = cvt_pk_bf16(v0[0], v0[1]); w.y = cvt_pk_bf16(v0[2], v0[3]); w.z = cvt_pk_bf16(v1[0], v1[1]); w.w = cvt_pk_bf16(v1[2], v1[3]);
                    *(u32x4*)(rowp + bj * HALF) = w; } }
    }
};
struct EpiGate8 {
    static constexpr bool PERM = true, AFTER_DRAIN = false;
    unsigned char* G; int ldc; float ascl; const unsigned long long* rowss; float inv_n, eps;
    const unsigned* qmax; const float* su;
    __device__ __forceinline__ void operator()(const f32x4 (&acc)[2][2][4][2], const Unit& u, int wr, int wc, int fr, int fq) const {
        typedef unsigned u32x2 __attribute__((ext_vector_type(2)));
        const int row0 = u.pm * BM + wr * 64 + fr, col0 = u.pn * BM + wc * 32 + 8 * fq;
        u32x2 gg[2][4][2];
#pragma unroll
        for (int ai = 0; ai < 2; ++ai)
#pragma unroll
            for (int m = 0; m < 4; ++m)
#pragma unroll
                for (int bj = 0; bj < 2; ++bj) gg[ai][m][bj] = *(const u32x2*)(G + (size_t)(row0 + ai * HALF + m * 16) * ldc + col0 + bj * HALF);
        float rsv[2][4];
#pragma unroll
        for (int ai = 0; ai < 2; ++ai)
#pragma unroll
            for (int m = 0; m < 4; ++m) { const int row = row0 + ai * HALF + m * 16; rsv[ai][m] = ascl * __uint_as_float(qmax[row]) / sqrtf((float)rowss[row] * inv_n + eps); }
        f32x4 sv[2][2];
#pragma unroll
        for (int bj = 0; bj < 2; ++bj) { sv[bj][0] = *(const f32x4*)(su + col0 + bj * HALF); sv[bj][1] = *(const f32x4*)(su + col0 + bj * HALF + 4); }
#pragma unroll
        for (int ai = 0; ai < 2; ++ai)
#pragma unroll
            for (int m = 0; m < 4; ++m) { const int row = row0 + ai * HALF + m * 16; unsigned char* rowp = G + (size_t)row * ldc + col0;
                const float rs = rsv[ai][m];
#pragma unroll
                for (int bj = 0; bj < 2; ++bj) { const u32x2 g = gg[ai][m][bj]; const f32x4 s0 = sv[bj][0], s1 = sv[bj][1];
                    unsigned long long gq = ((unsigned long long)g.y << 32) | (unsigned long long)g.x, outq = 0ull;
                    const f32x4 v0 = acc[ai][bj][m][0], v1 = acc[ai][bj][m][1];
                    while (__any(gq != 0ull)) {
                        if (gq != 0ull) {
                            const int p = __builtin_ctzll(gq) >> 3;
                            const float gv = __builtin_amdgcn_cvt_f32_fp8((int)(unsigned)(gq >> (8 * p)), 0);
                            const float a01 = (p & 1) ? v0[1] : v0[0], a23 = (p & 1) ? v0[3] : v0[2], a45 = (p & 1) ? v1[1] : v1[0], a67 = (p & 1) ? v1[3] : v1[2];
                            const float a03 = (p & 2) ? a23 : a01, a47 = (p & 2) ? a67 : a45;
                            const float s01 = (p & 1) ? s0[1] : s0[0], s23 = (p & 1) ? s0[3] : s0[2], s45 = (p & 1) ? s1[1] : s1[0], s67 = (p & 1) ? s1[3] : s1[2];
                            const float s03 = (p & 2) ? s23 : s01, s47 = (p & 2) ? s67 : s45;
                            const float x = ((p & 4) ? a47 : a03) * (((p & 4) ? s47 : s03) * rs);
                            const f32x2 ge = gelu_pk((f32x2){x, 0.f});
                            const unsigned byte = (unsigned)__builtin_amdgcn_cvt_pk_fp8_f32(ge.x * gv, 0.f, 0, false) & 0xffu;
                            outq |= (unsigned long long)byte << (8 * p);
                            gq &= ~(0xffull << (8 * p));
                        }
                    }
                    if ((g.x | g.y) != 0u) { u32x2 w; w.x = (unsigned)outq; w.y = (unsigned)(outq >> 32); *(u32x2*)(rowp + bj * HALF) = w; } } }
    }
};
}

constexpr int NB = 4, T = 4096, D = 4096, M = NB * T;
constexpr int NPROJ = 12288;
constexpr int NMEM = 256, XW = 512, PQW = 2048, NEXP = 16384;
constexpr float RMS_EPS = 1e-6f;
constexpr int NWAVES = 8;

constexpr size_t MiB = 1u << 20;
constexpr size_t WS_CTL = 0, CTL_ZERO_BYTES = 1 * MiB;
constexpr int LDH = D, LDW = D, LDAO = D, LDP = NPROJ, LDXO = XW, LDH8 = D, LDU8 = D, LDG8 = NEXP, LDV8 = NEXP;
constexpr size_t WS_KMEAN = 1 * MiB;
constexpr size_t WS_SUBK = 2 * MiB;
constexpr size_t WS_MEMN = 4 * MiB;
constexpr size_t WS_KVMEM = 12 * MiB;
constexpr size_t WS_WXQ = 16 * MiB;
constexpr size_t WS_WXKV = 21 * MiB;
constexpr size_t WS_WXO = 30 * MiB;
constexpr size_t WS_WPQ = 35 * MiB;
constexpr size_t WS_WOUT = 53 * MiB;
constexpr size_t WS_WIN8 = 88 * MiB;
constexpr size_t WS_PQ = 88 * MiB;
constexpr size_t WS_AO8 = 88 * MiB;
constexpr size_t WS_XQ = 152 * MiB;
constexpr size_t WS_XO = 168 * MiB;
constexpr size_t WS_U8 = 191 * MiB;
constexpr size_t WS_VT8 = 257 * MiB;
constexpr size_t WS_H = 322 * MiB;
constexpr size_t WS_H8 = 452 * MiB;
constexpr size_t WS_PROJ = 518 * MiB;
constexpr size_t WS_AO = 904 * MiB;
constexpr size_t WS_G8 = 518 * MiB;
constexpr size_t WS_END = 1034 * MiB;
static_assert(WS_WXQ + (size_t)XW * LDW * 2 <= WS_WXKV && WS_WXKV + (size_t)2 * XW * LDW * 2 <= WS_WXO && WS_WXO + (size_t)D * LDXO * 2 <= WS_WPQ && WS_WPQ + (size_t)PQW * LDW * 2 <= WS_WOUT && WS_WOUT + (size_t)D * LDW * 2 <= WS_WIN8, "ws map 1");
static_assert(WS_WIN8 + (size_t)NPROJ * D <= WS_U8 && WS_XO + (size_t)M * LDXO * 2 <= WS_U8 && WS_U8 + (size_t)NEXP * LDU8 <= WS_VT8 && WS_VT8 + (size_t)D * LDV8 <= WS_H && WS_H + (size_t)M * LDH * 2 <= WS_H8, "ws map 2");
static_assert(WS_H8 + (size_t)M * LDH8 <= WS_PROJ && WS_PROJ + (size_t)M * LDP * 2 <= WS_AO && WS_AO + (size_t)M * LDAO * 2 <= WS_END && WS_G8 + (size_t)M * LDG8 <= WS_AO, "ws map 3");
constexpr float U_SCL = 64.f, V_SCL = 4.f, G_SCL = 16.f, WO_SCL = 64.f;
constexpr int CW_BAR = 4096;
constexpr size_t WS_CMAX_WIN = 524288 + 65536;
constexpr size_t WS_SA_H = 1 * MiB + 512 * 1024 + 65536;
constexpr size_t WS_ROWMAX1 = 655360;
constexpr size_t WS_SU = 786432;
constexpr size_t WS_CMAX_WPQ = 720896;
constexpr size_t WS_H8I = 776 * MiB;
constexpr size_t WS_CMAX_WOUT = 524288;
constexpr size_t WS_SA_AO = 1 * MiB + 512 * 1024;
constexpr int CW_QUEUE = 8192;
constexpr size_t WS_ROWSS1 = 65536, WS_ROWSS2 = 262144;

constexpr int RING_BYTES = 131072;
constexpr int MISC_OFF = RING_BYTES + 320;
constexpr int LDS_BYTES = 147456;

#define GAS __attribute__((address_space(1)))
#define LAS __attribute__((address_space(3)))
typedef unsigned short bf16;
typedef unsigned v4u __attribute__((ext_vector_type(4)));
typedef float f32x4 __attribute__((ext_vector_type(4)));
typedef short bf16x8 __attribute__((ext_vector_type(8)));
typedef GAS unsigned gu32;
typedef GAS unsigned long long gu64;
#define RLX_AGENT __ATOMIC_RELAXED, __HIP_MEMORY_SCOPE_AGENT
#define LDS_WAIT() asm volatile("s_waitcnt lgkmcnt(0)" ::: "memory")
#define VM_WAIT() asm volatile("s_waitcnt vmcnt(0)" ::: "memory")
__device__ __forceinline__ unsigned long long rt() { return __builtin_amdgcn_s_memrealtime(); }
__device__ __forceinline__ unsigned f2bf(float f) { unsigned u = __builtin_bit_cast(unsigned, f); return (u + 0x7fffu + ((u >> 16) & 1u)) >> 16; }
__device__ __forceinline__ unsigned pk2(float lo, float hi) { return f2bf(lo) | (f2bf(hi) << 16); }

#define XB_TMO      128
#define XB_XCNT(j)  (256  + 64 * (j))
#define XB_XSUB(j)  (1280 + 64 * (j))
#define XB_XGEN(j)  (2304 + 64 * (j))
#define XB_TOP      3328
#define XB_TOPGEN   3392
#define XCD_BAR_WORDS 3456
#define XB_SPIN_CAP (1u << 18)

__device__ __forceinline__ unsigned xb_ld(unsigned* p)              { return __hip_atomic_load(p, __ATOMIC_RELAXED, __HIP_MEMORY_SCOPE_AGENT); }
__device__ __forceinline__ unsigned xb_add(unsigned* p, unsigned v) { return __hip_atomic_fetch_add(p, v, __ATOMIC_RELAXED, __HIP_MEMORY_SCOPE_AGENT); }
__device__ __forceinline__ unsigned xb_xcc_id() { return (unsigned)__builtin_amdgcn_s_getreg((3 << 11) | 20) & 0xFu; }
#define XB_SPIN(cond, bar) do { unsigned _sp = 0; while (cond) { __builtin_amdgcn_s_sleep(1); \
    if ((++_sp & 255u) == 0u) { if (xb_ld(&(bar)[XB_TMO])) break; if (_sp > XB_SPIN_CAP) { atomicAdd(&(bar)[XB_TMO], 1u); break; } } } } while (0)

struct XcdBarrier {
    unsigned* bar; unsigned x;
    volatile LAS unsigned* st;
};

__device__ __forceinline__ XcdBarrier xcd_barrier_post(unsigned* bar, volatile LAS unsigned* st) {
    XcdBarrier b; b.bar = bar; b.x = xb_xcc_id(); b.st = st;
    if (threadIdx.x == 0) (void)xb_add(&bar[XB_XCNT(b.x)], 1u);
    return b;
}
__device__ __forceinline__ void xcd_barrier_complete(unsigned* bar, unsigned x, unsigned& nloc, unsigned& nx) {
    const unsigned G = gridDim.x * gridDim.y * gridDim.z;
    unsigned sum, cnt, mine, sp = 0u;
    for (;;) {
        sum = 0u; cnt = 0u; mine = 0u;
#pragma unroll
        for (unsigned j = 0; j < 16; ++j) { const unsigned c = xb_ld(&bar[XB_XCNT(j)]); sum += c; cnt += (c > 0u) ? 1u : 0u; mine = (j == x) ? c : mine; }
        if (sum == G) break;
        __builtin_amdgcn_s_sleep(1);
        if ((++sp & 255u) == 0u) { if (xb_ld(&bar[XB_TMO])) break; if (sp > XB_SPIN_CAP) { atomicAdd(&bar[XB_TMO], 1u); break; } }
    }
    nloc = mine > 0u ? mine : 1u; nx = cnt > 0u ? cnt : 1u;
}

__device__ __forceinline__ void xcd_barrier(const XcdBarrier& b) {
    asm volatile("s_waitcnt vmcnt(0)" ::: "memory");
    __syncthreads();
    if (threadIdx.x == 0) {
        unsigned* bar = b.bar;
        __builtin_amdgcn_s_waitcnt(0);
        unsigned nloc = b.st[0], nx = b.st[1];
        if (nloc == 0u) { xcd_barrier_complete(bar, b.x, nloc, nx); b.st[0] = nloc; b.st[1] = nx; }
        const unsigned old = xb_add(&bar[XB_XSUB(b.x)], 1u);
        const unsigned gen = old / nloc;
        if (old + 1u == (gen + 1u) * nloc) {
            __builtin_amdgcn_fence(__ATOMIC_RELEASE, "agent");
            asm volatile("s_waitcnt vmcnt(0)" ::: "memory");
            const unsigned og = xb_add(&bar[XB_TOP], 1u);
            const unsigned tg = og / nx;
            if (og + 1u == (tg + 1u) * nx) xb_add(&bar[XB_TOPGEN], 1u);
            else XB_SPIN(xb_ld(&bar[XB_TOPGEN]) == tg, bar);
            __builtin_amdgcn_fence(__ATOMIC_ACQUIRE, "agent");
            xb_add(&bar[XB_XGEN(b.x)], 1u);
            asm volatile("s_waitcnt vmcnt(0)" ::: "memory");
        } else {
            XB_SPIN(xb_ld(&bar[XB_XGEN(b.x)]) == gen, bar);
            __builtin_amdgcn_fence(__ATOMIC_ACQUIRE, "agent");
            asm volatile("s_waitcnt vmcnt(0)" ::: "memory");
        }
    }
    __syncthreads();
}
typedef unsigned v2u __attribute__((ext_vector_type(2)));
typedef float f32x16 __attribute__((ext_vector_type(16)));
typedef short s16x4 __attribute__((ext_vector_type(4)));
typedef short v2s __attribute__((ext_vector_type(2)));
#define SBAR() __builtin_amdgcn_sched_barrier(0)

__device__ __forceinline__ float bflo(unsigned w) { return __uint_as_float(w << 16); }
__device__ __forceinline__ float bfhi(unsigned w) { return __uint_as_float(w & 0xffff0000u); }
__device__ __forceinline__ float wave_sum(float v) {
#pragma unroll
    for (int o = 1; o < 64; o <<= 1) v += __shfl_xor(v, o);
    return v;
}
__device__ __forceinline__ void pair_get(unsigned x, unsigned& v0, unsigned& v1) { auto rr = __builtin_amdgcn_permlane32_swap(x, x, false, false); v0 = rr[0]; v1 = rr[1]; }
__device__ __forceinline__ float pair_max(float x) { unsigned a, b; pair_get(__float_as_uint(x), a, b); return fmaxf(__uint_as_float(a), __uint_as_float(b)); }
__device__ __forceinline__ float pair_sum(float x) { unsigned a, b; pair_get(__float_as_uint(x), a, b); return __uint_as_float(a) + __uint_as_float(b); }
__device__ __forceinline__ int pair_sumi(int x) { unsigned a, b; pair_get((unsigned)x, a, b); return (int)(a + b); }
__device__ __forceinline__ float pair_other(float x, int hi) { unsigned a, b; pair_get(__float_as_uint(x), a, b); return __uint_as_float(hi ? a : b); }


__device__ __forceinline__ unsigned pk4_fp8(float a, float b, float c, float e) { int t = 0; t = __builtin_amdgcn_cvt_pk_fp8_f32(a, b, t, false); t = __builtin_amdgcn_cvt_pk_fp8_f32(c, e, t, true); return (unsigned)t; }
__device__ __forceinline__ unsigned pk4_i8(float a, float b, float c, float e) { unsigned w = 0u;
    w = __builtin_amdgcn_cvt_pk_u8_f32(rintf(a) + 128.f, 0, w); w = __builtin_amdgcn_cvt_pk_u8_f32(rintf(b) + 128.f, 1, w); w = __builtin_amdgcn_cvt_pk_u8_f32(rintf(c) + 128.f, 2, w); w = __builtin_amdgcn_cvt_pk_u8_f32(rintf(e) + 128.f, 3, w);
    return w ^ 0x80808080u; }
__device__ __forceinline__ void colmax_item(const float* W, int N, int k0, int n0, unsigned* cmax, LAS f32x4* scr, int tid, const float* kgain = nullptr) {
    const int q = tid & 63, rp = tid >> 6;
    f32x4 mx = {0.f, 0.f, 0.f, 0.f};
#pragma unroll 8
    for (int j = 0; j < 32; ++j) { f32x4 v = *(const GAS f32x4*)(W + (size_t)(k0 + rp + 8 * j) * N + n0 + 4 * q); if (kgain) v = v * kgain[k0 + rp + 8 * j];
        mx = (f32x4){fmaxf(mx[0], fabsf(v[0])), fmaxf(mx[1], fabsf(v[1])), fmaxf(mx[2], fabsf(v[2])), fmaxf(mx[3], fabsf(v[3]))}; }
    __syncthreads();
    scr[rp * 64 + q] = mx;
    __syncthreads();
    if (tid < 64) {
#pragma unroll
        for (int w = 1; w < 8; ++w) { const f32x4 o = scr[w * 64 + q]; mx = (f32x4){fmaxf(mx[0], o[0]), fmaxf(mx[1], o[1]), fmaxf(mx[2], o[2]), fmaxf(mx[3], o[3])}; }
#pragma unroll
        for (int i = 0; i < 4; ++i) atomicMax(cmax + n0 + 4 * q + i, __float_as_uint(mx[i])); }
}
template <bool F8> struct TrRegs { f32x4 v[F8 ? 16 : 8]; };
template <bool F8> __device__ __forceinline__ void transpose_load(TrRegs<F8>& R, const float* W, int N, int nblk, int item, int tid) {
    constexpr int KI = F8 ? 128 : 64, RW = F8 ? 16 : 8;
    const int wave = tid >> 6, lane = tid & 63;
    const int kb = item / nblk, nb = item % nblk, k0 = KI * kb, n0 = 256 * nb;
    const float* src = W + (size_t)(k0 + RW * wave) * N + n0 + 4 * lane;
#pragma unroll
    for (int j = 0; j < RW; ++j) R.v[j] = *(const GAS f32x4*)(src + (size_t)j * N);
}
template <bool F8> __device__ __forceinline__ void transpose_flush(TrRegs<F8>& R, const float* W, int K, int N, void* WT, int ldo, float scl, const float* kgain, LAS unsigned* Tl, int item, int next_item, int tid, const unsigned* cmax = nullptr, int nblk = 0) {
    if (nblk == 0) nblk = N / 256;
    constexpr int KI = F8 ? 128 : 64, RW = F8 ? 16 : 8;
    const int wave = tid >> 6, lane = tid & 63;
    const int kb = item / nblk, nb = item % nblk, k0 = KI * kb, n0 = 256 * nb;
    if (kgain) {
#pragma unroll
        for (int j = 0; j < RW; ++j) R.v[j] = R.v[j] * kgain[k0 + RW * wave + j]; }
    float qs[4] = {0.f, 0.f, 0.f, 0.f};
    if (F8 && cmax) { const v4u cm = *(const GAS v4u*)(cmax + n0 + 4 * lane);
        qs[0] = cm.x ? 127.f / __uint_as_float(cm.x) : 0.f; qs[1] = cm.y ? 127.f / __uint_as_float(cm.y) : 0.f; qs[2] = cm.z ? 127.f / __uint_as_float(cm.z) : 0.f; qs[3] = cm.w ? 127.f / __uint_as_float(cm.w) : 0.f; }
    __syncthreads();
#pragma unroll
    for (int jq = 0; jq < 4; ++jq)
#pragma unroll
        for (int i = 0; i < 4; ++i) { unsigned w;
            if constexpr (F8) { if (cmax) { const float s = qs[i]; w = pk4_i8(R.v[4 * jq][i] * s, R.v[4 * jq + 1][i] * s, R.v[4 * jq + 2][i] * s, R.v[4 * jq + 3][i] * s); }
                else w = pk4_fp8(R.v[4 * jq][i] * scl, R.v[4 * jq + 1][i] * scl, R.v[4 * jq + 2][i] * scl, R.v[4 * jq + 3][i] * scl); }
            else w = pk2(R.v[2 * jq][i], R.v[2 * jq + 1][i]);
            Tl[(4 * lane + i) * 32 + ((4 * wave + jq) ^ (4 * (lane & 7)))] = w; }
    __syncthreads();
    if (next_item >= 0) transpose_load<F8>(R, W, N, nblk, next_item, tid);
    const int n = tid >> 1, h = tid & 1;
    unsigned char* dst = (unsigned char*)WT + ((size_t)(n0 + n) * ldo + k0) * (F8 ? 1 : 2) + 64 * h;
#pragma unroll
    for (int q = 0; q < 4; ++q) { const v4u t = *(const LAS v4u*)(Tl + n * 32 + ((16 * h + 4 * q) ^ (4 * ((n >> 2) & 7)))); *(GAS v4u*)(dst + 16 * q) = t; }
}
template <bool F8> __device__ __forceinline__ void transpose_matrix(const float* W, int K, int N, void* WT, int ldo, float scl, const float* kgain, LAS unsigned* Tl, int first, int stride, int NI, int tid, const unsigned* cmax = nullptr, int nblk = 0) {
    if (nblk == 0) nblk = N / 256;
    if (first >= NI) return;
    TrRegs<F8> R; transpose_load<F8>(R, W, N, nblk, first, tid);
    for (int it = first; it < NI; it += stride) { const int nx = it + stride < NI ? it + stride : -1; transpose_flush<F8>(R, W, K, N, WT, ldo, scl, kgain, Tl, it, nx, tid, cmax, nblk); }
}
template <bool WITH_F8> __device__ __forceinline__ void rms_row_4096(const float* xrow, const float* g, bf16* orow, unsigned char* orow8, int lane, float* sa = nullptr) {
    const GAS f32x4* xr = (const GAS f32x4*)xrow + lane;
    f32x4 v[16]; float s = 0.f;
#pragma unroll
    for (int j = 0; j < 16; ++j) { v[j] = xr[64 * j]; s += (v[j].x * v[j].x + v[j].y * v[j].y) + (v[j].z * v[j].z + v[j].w * v[j].w); }
    const float r = 1.0f / sqrtf(wave_sum(s) * (1.f / 4096.f) + RMS_EPS);
    const GAS f32x4* gr = (const GAS f32x4*)g + lane;
    GAS v2u* o8 = (GAS v2u*)orow + lane;
    float amax = 0.f;
#pragma unroll
    for (int j = 0; j < 16; ++j) { const f32x4 gg = gr[64 * j]; v[j] = (f32x4){v[j].x * r * gg.x, v[j].y * r * gg.y, v[j].z * r * gg.z, v[j].w * r * gg.w};
        if (orow) { v2u w; w.x = pk2(v[j].x, v[j].y); w.y = pk2(v[j].z, v[j].w); o8[64 * j] = w; }
        amax = fmaxf(fmaxf(amax, fmaxf(fabsf(v[j].x), fabsf(v[j].y))), fmaxf(fabsf(v[j].z), fabsf(v[j].w))); }
    if constexpr (WITH_F8) {
        if (sa) {
#pragma unroll
            for (int o = 1; o < 64; o <<= 1) amax = fmaxf(amax, __shfl_xor(amax, o));
            const float inv = amax > 0.f ? 127.f / amax : 0.f;
            if (lane == 0) *sa = amax * (1.f / 127.f);
#pragma unroll
            for (int j = 0; j < 16; ++j) ((GAS unsigned*)orow8)[lane + 64 * j] = pk4_i8(v[j].x * inv, v[j].y * inv, v[j].z * inv, v[j].w * inv);
        } else {
#pragma unroll
            for (int j = 0; j < 16; ++j) ((GAS unsigned*)orow8)[lane + 64 * j] = pk4_fp8(v[j].x, v[j].y, v[j].z, v[j].w); }
    }
}
__device__ __forceinline__ void cvt_f32_fp8(const float* src, unsigned char* dst, int ldo, size_t n, float scl, const float* cgain, int ncol, size_t gtid, size_t gthreads) {
    for (size_t i = gtid * 16; i < n; i += gthreads * 16) { f32x4 a = *(const GAS f32x4*)(src + i), b = *(const GAS f32x4*)(src + i + 4), c = *(const GAS f32x4*)(src + i + 8), e = *(const GAS f32x4*)(src + i + 12);
        { const float* gp = cgain + (i % (size_t)ncol); a = a * *(const GAS f32x4*)gp; b = b * *(const GAS f32x4*)(gp + 4); c = c * *(const GAS f32x4*)(gp + 8); e = e * *(const GAS f32x4*)(gp + 12); }
        v4u o; o.x = pk4_fp8(a.x * scl, a.y * scl, a.z * scl, a.w * scl); o.y = pk4_fp8(b.x * scl, b.y * scl, b.z * scl, b.w * scl); o.z = pk4_fp8(c.x * scl, c.y * scl, c.z * scl, c.w * scl); o.w = pk4_fp8(e.x * scl, e.y * scl, e.z * scl, e.w * scl);
        *(GAS v4u*)(dst + (i / (size_t)ncol) * (size_t)ldo + (i % (size_t)ncol)) = o; }
}
__device__ __forceinline__ void cvt_u_fp6(const float* src, unsigned char* dst, int ldo, float* su, const float* cgain, int nrows, int tid) {
    typedef float v16f_t __attribute__((ext_vector_type(16)));
    typedef unsigned v6u_t __attribute__((ext_vector_type(6)));
    typedef unsigned u32x2_t __attribute__((ext_vector_type(2)));
    const int wave = tid >> 6, lane = tid & 63;
    for (int r = wave; r < nrows; r += 8) { const float* rp = src + (size_t)r * 4096;
        v16f_t X[2], Y[2]; float mx = 0.f;
#pragma unroll
        for (int h = 0; h < 2; ++h) { const int g = lane + 64 * h, kt = g >> 2, gq = g & 3, cb = (kt >> 1) * 256 + (((kt & 1) << 1) | (gq >> 1)) * 32 + (gq & 1) * 8;
#pragma unroll
            for (int bj = 0; bj < 2; ++bj)
#pragma unroll
                for (int n = 0; n < 2; ++n) { const int c = cb + bj * 128 + n * 16;
                    const f32x4 a = *(const GAS f32x4*)(rp + c) * *(const GAS f32x4*)(cgain + c), b = *(const GAS f32x4*)(rp + c + 4) * *(const GAS f32x4*)(cgain + c + 4);
#pragma unroll
                    for (int j = 0; j < 4; ++j) { X[h][(bj * 2 + n) * 4 + j] = a[j]; Y[h][(bj * 2 + n) * 4 + j] = b[j]; mx = fmaxf(mx, fmaxf(fabsf(a[j]), fabsf(b[j]))); } } }
        mx = fmaxf(mx, pg8::dpp_f<0xB1>(mx)); mx = fmaxf(mx, pg8::dpp_f<0x4E>(mx)); mx = fmaxf(mx, pg8::dpp_f<0x141>(mx)); mx = fmaxf(mx, pg8::dpp_f<0x128>(mx)); mx = pg8::fq4_max(mx);
        const float s = mx > 0.f ? 7.5f / mx : 0.f;
        if (lane == 0) su[r] = mx * (1.f / 7.5f);
#pragma unroll
        for (int h = 0; h < 2; ++h) { const int g = lane + 64 * h;
#pragma unroll
            for (int i = 0; i < 16; ++i) { X[h][i] = __builtin_amdgcn_fmed3f(X[h][i] * s, -7.5f, 7.5f); Y[h][i] = __builtin_amdgcn_fmed3f(Y[h][i] * s, -7.5f, 7.5f); }
            const v6u_t o = __builtin_amdgcn_cvt_scalef32_2xpk16_fp6_f32(X[h], Y[h], 1.0f);
            unsigned char* dp = dst + (size_t)r * ldo + (g >> 2) * 128 + (g & 3) * 16;
            *(GAS v4u*)dp = (v4u){o[0], o[1], o[2], o[3]}; *(GAS u32x2_t*)(dp + 64) = (u32x2_t){o[4], o[5]}; }
    }
}
__device__ __forceinline__ void cvt_f32_bf16(const float* src, bf16* dst, size_t n, size_t gtid, size_t gthreads) {
    for (size_t i = gtid * 8; i < n; i += gthreads * 8) { const f32x4 a = *(const GAS f32x4*)(src + i), b = *(const GAS f32x4*)(src + i + 4);
        v4u o; o.x = pk2(a.x, a.y); o.y = pk2(a.z, a.w); o.z = pk2(b.x, b.y); o.w = pk2(b.z, b.w); *(GAS v4u*)(dst + i) = o; }
}

__device__ __forceinline__ void qknorm_unit(bf16* PROJ, int row0, int col0, const float* g, bf16* km, LAS float* scr, int tid) {
    const int rr = tid >> 4, ch = tid & 15, wid = tid >> 6, lane = tid & 63;
    float gg[8];
#pragma unroll
    for (int j = 0; j < 8; ++j) gg[j] = g[ch * 8 + j];
    float cs[8] = {0.f, 0.f, 0.f, 0.f, 0.f, 0.f, 0.f, 0.f};
    v4u wv[8];
#pragma unroll
    for (int p = 0; p < 8; ++p) wv[p] = *(const GAS v4u*)(PROJ + (size_t)(row0 + p * 32 + rr) * LDP + col0 + ch * 8);
#pragma unroll
    for (int p = 0; p < 8; ++p) {
        bf16* ptr = PROJ + (size_t)(row0 + p * 32 + rr) * LDP + col0 + ch * 8;
        const v4u w = wv[p];
        float x[8] = {bflo(w.x), bfhi(w.x), bflo(w.y), bfhi(w.y), bflo(w.z), bfhi(w.z), bflo(w.w), bfhi(w.w)};
        float ss = 0.f;
#pragma unroll
        for (int j = 0; j < 8; ++j) ss += x[j] * x[j];
        ss += __shfl_xor(ss, 1); ss += __shfl_xor(ss, 2); ss += __shfl_xor(ss, 4); ss += __shfl_xor(ss, 8);
        const float r = 1.0f / sqrtf(ss * (1.f / 128.f) + RMS_EPS);
#pragma unroll
        for (int j = 0; j < 8; ++j) { x[j] = x[j] * r * gg[j]; cs[j] += x[j]; }
        v4u o; o.x = pk2(x[0], x[1]); o.y = pk2(x[2], x[3]); o.z = pk2(x[4], x[5]); o.w = pk2(x[6], x[7]);
        *(GAS v4u*)ptr = o;
    }
    if (km) {
#pragma unroll
        for (int j = 0; j < 8; ++j) { cs[j] += __shfl_xor(cs[j], 16); cs[j] += __shfl_xor(cs[j], 32); }
        if (lane < 16) {
#pragma unroll
            for (int j = 0; j < 8; ++j) scr[wid * 128 + ch * 8 + j] = cs[j]; }
        __syncthreads();
        if (tid < 128) { float s = 0.f;
#pragma unroll
            for (int w = 0; w < 8; ++w) s += scr[w * 128 + tid];
            km[tid] = (bf16)f2bf(s * (1.f / 256.f)); }
        __syncthreads();
    }
}

__device__ __forceinline__ void outnorm_row(const bf16* row, unsigned char* orow8, float* sa, const float* gm, const float* gs, int lane) {
    v4u w[8]; float s0 = 0.f, s1 = 0.f;
#pragma unroll
    for (int j = 0; j < 8; ++j) { w[j] = *(const GAS v4u*)(row + (size_t)(lane + 64 * j) * 8);
        const float x[8] = {bflo(w[j].x), bfhi(w[j].x), bflo(w[j].y), bfhi(w[j].y), bflo(w[j].z), bfhi(w[j].z), bflo(w[j].w), bfhi(w[j].w)};
        float ss = 0.f;
#pragma unroll
        for (int k = 0; k < 8; ++k) ss += x[k] * x[k];
        if (j < 4) s0 += ss; else s1 += ss; }
    const float r0 = 1.0f / sqrtf(wave_sum(s0) * (1.f / 2048.f) + RMS_EPS), r1 = 1.0f / sqrtf(wave_sum(s1) * (1.f / 2048.f) + RMS_EPS);
    float y[8][8]; float amax = 0.f;
#pragma unroll
    for (int j = 0; j < 8; ++j) { const int c = (lane + 64 * j) * 8; const float* g = (j < 4) ? (gm + c) : (gs + c - 2048); const float r = (j < 4) ? r0 : r1;
        const f32x4 ga = *(const GAS f32x4*)g, gb = *(const GAS f32x4*)(g + 4);
        y[j][0] = bflo(w[j].x) * r * ga.x; y[j][1] = bfhi(w[j].x) * r * ga.y; y[j][2] = bflo(w[j].y) * r * ga.z; y[j][3] = bfhi(w[j].y) * r * ga.w;
        y[j][4] = bflo(w[j].z) * r * gb.x; y[j][5] = bfhi(w[j].z) * r * gb.y; y[j][6] = bflo(w[j].w) * r * gb.z; y[j][7] = bfhi(w[j].w) * r * gb.w;
#pragma unroll
        for (int k = 0; k < 8; ++k) amax = fmaxf(amax, fabsf(y[j][k])); }
#pragma unroll
    for (int o = 1; o < 64; o <<= 1) amax = fmaxf(amax, __shfl_xor(amax, o));
    const float inv = amax > 0.f ? 127.f / amax : 0.f;
    if (lane == 0) *sa = amax * (1.f / 127.f);
#pragma unroll
    for (int j = 0; j < 8; ++j) { v2u o; o.x = pk4_i8(y[j][0] * inv, y[j][1] * inv, y[j][2] * inv, y[j][3] * inv); o.y = pk4_i8(y[j][4] * inv, y[j][5] * inv, y[j][6] * inv, y[j][7] * inv);
        *(GAS v2u*)(orow8 + (lane + 64 * j) * 8) = o; }
}

#define KSWZ(row, colB) ((row) * 256 + ((colB) ^ (((row) & 7) << 4)))
constexpr int ATT_TILE = 16384;
__device__ __forceinline__ int v_st(int k, int c) { const int kk = (k & ~0xC) | ((k & 4) << 1) | ((k & 8) >> 1); return ((kk >> 3) * 4 + (c >> 5)) * 512 + ((kk & 7) * 32 + (c & 31)) * 2; }
__device__ __forceinline__ int v_rd_base(int lane) { return ((lane & 3) << 3) | (((lane >> 2) & 3) << 6) | (((lane >> 4) & 1) << 5) | (((lane >> 5) & 1) << 8); }
constexpr int v_rd_off(int d0, int ks, int half) { return d0 * 512 + ks * 4096 + half * 2048; }
__device__ __forceinline__ int crow(int r, int hi) { return (r & 3) + 8 * (r >> 2) + 4 * hi; }
__device__ __forceinline__ unsigned cvtpk(float lo, float hi) { unsigned r; asm volatile("v_cvt_pk_bf16_f32 %0, %1, %2" : "=v"(r) : "v"(lo), "v"(hi)); return r; }

__device__ __forceinline__ void qkt64(f32x16& p0, f32x16& p1, const LAS char* Kt, int r32, int hi, const bf16x8* qr) {
    p0 = f32x16{}; p1 = f32x16{};
    const LAS char* kb[4];
#pragma unroll
    for (int dd = 0; dd < 4; ++dd) kb[dd] = Kt + KSWZ(r32, (dd * 16 + hi * 8) * 2);
#pragma unroll
    for (int d0 = 0; d0 < 8; ++d0) { const LAS char* a = kb[d0 & 3] + (d0 >> 2) * 128;
        const bf16x8 b0 = *(const LAS bf16x8*)a;
        const bf16x8 b1 = *(const LAS bf16x8*)(a + 32 * 256);
        p0 = __builtin_amdgcn_mfma_f32_32x32x16_bf16(b0, qr[d0], p0, 0, 0, 0);
        p1 = __builtin_amdgcn_mfma_f32_32x32x16_bf16(b1, qr[d0], p1, 0, 0, 0); }
}
__device__ __forceinline__ void qkt32(f32x16& p0, const LAS char* Kt, int r32, int hi, const bf16x8* qr) {
    p0 = f32x16{};
#pragma unroll
    for (int d0 = 0; d0 < 8; ++d0) { const bf16x8 b0 = *(const LAS bf16x8*)(Kt + KSWZ(r32, (d0 * 16 + hi * 8) * 2));
        p0 = __builtin_amdgcn_mfma_f32_32x32x16_bf16(b0, qr[d0], p0, 0, 0, 0); }
}
__device__ __forceinline__ void pack_p(const f32x16& p0, const f32x16& p1, bf16x8& pa0, bf16x8& pa1, bf16x8& pa2, bf16x8& pa3) {
#define PK4(P, B_, OUT) do { unsigned a0 = cvtpk(P[B_+0], P[B_+1]), a1 = cvtpk(P[B_+2], P[B_+3]);                          \
        unsigned b0 = cvtpk(P[B_+4], P[B_+5]), b1 = cvtpk(P[B_+6], P[B_+7]);                                             \
        auto r0 = __builtin_amdgcn_permlane32_swap(a0, b0, false, false); auto r1 = __builtin_amdgcn_permlane32_swap(a1, b1, false, false); \
        v4u w = {r0[0], r1[0], r0[1], r1[1]}; OUT = __builtin_bit_cast(bf16x8, w); } while (0)
    PK4(p0, 0, pa0); PK4(p0, 8, pa1); PK4(p1, 0, pa2); PK4(p1, 8, pa3);
#undef PK4
}
__device__ __forceinline__ void pv64(f32x16* o, int vb0, bf16x8 pa0, bf16x8 pa1, bf16x8 pa2, bf16x8 pa3) {
#define TRRD(dst, off) asm volatile("ds_read_b64_tr_b16 %0, %1 offset:%2" : "=&v"(dst) : "v"(vb0), "i"(off) : "memory")
#define PV_D0(d0) do { s16x4 l0, l1, l2, l3, h0, h1, h2, h3; constexpr int b_ = v_rd_off(d0, 0, 0); \
        TRRD(l0, b_); TRRD(h0, b_ + 2048); TRRD(l1, b_ + 4096); TRRD(h1, b_ + 6144); TRRD(l2, b_ + 8192); TRRD(h2, b_ + 10240); TRRD(l3, b_ + 12288); TRRD(h3, b_ + 14336); \
        asm volatile("s_waitcnt lgkmcnt(0)" ::: "memory"); SBAR();   \
        o[d0] = __builtin_amdgcn_mfma_f32_32x32x16_bf16(pa0, (bf16x8){l0[0], l0[1], l0[2], l0[3], h0[0], h0[1], h0[2], h0[3]}, o[d0], 0, 0, 0);   \
        o[d0] = __builtin_amdgcn_mfma_f32_32x32x16_bf16(pa1, (bf16x8){l1[0], l1[1], l1[2], l1[3], h1[0], h1[1], h1[2], h1[3]}, o[d0], 0, 0, 0);   \
        o[d0] = __builtin_amdgcn_mfma_f32_32x32x16_bf16(pa2, (bf16x8){l2[0], l2[1], l2[2], l2[3], h2[0], h2[1], h2[2], h2[3]}, o[d0], 0, 0, 0);   \
        o[d0] = __builtin_amdgcn_mfma_f32_32x32x16_bf16(pa3, (bf16x8){l3[0], l3[1], l3[2], l3[3], h3[0], h3[1], h3[2], h3[3]}, o[d0], 0, 0, 0); } while (0)
    PV_D0(0); PV_D0(1); PV_D0(2); PV_D0(3);
#undef PV_D0
#undef TRRD
}
__device__ __forceinline__ void store_o(const f32x16* o, const float* scl, bf16* Ow, int ld, int r32, int hi) {
#pragma unroll
    for (int r = 0; r < 16; ++r) { const int orow = crow(r, hi);
#pragma unroll
        for (int d0 = 0; d0 < 4; ++d0) { const float v = o[d0][r] * scl[r]; const float vn = pg8::dpp_f<0xB1>(v);
            if ((r32 & 1) == 0) *(GAS unsigned*)(Ow + (size_t)orow * ld + d0 * 32 + r32) = pk2(v, vn); } }
}
__device__ __forceinline__ void softmax_step(f32x16& p0, f32x16& p1, float& m, float& l, f32x16* o, LAS float* al_l, int r32, int hi) {
    float pmax = p0[0];
#pragma unroll
    for (int r = 1; r < 16; ++r) pmax = fmaxf(pmax, p0[r]);
#pragma unroll
    for (int r = 0; r < 16; ++r) pmax = fmaxf(pmax, p1[r]);
    pmax = pair_max(pmax);
    const float mn = fmaxf(m, pmax);
    const float alpha = __builtin_amdgcn_exp2f(m - mn); m = mn;
    float ps = 0.f;
#pragma unroll
    for (int r = 0; r < 16; ++r) { p0[r] = __builtin_amdgcn_exp2f(p0[r] - mn); ps += p0[r]; }
#pragma unroll
    for (int r = 0; r < 16; ++r) { p1[r] = __builtin_amdgcn_exp2f(p1[r] - mn); ps += p1[r]; }
    ps = pair_sum(ps);
    l = l * alpha + ps;
    if (__any(alpha < 1.f)) {
        if (hi == 0) al_l[r32] = alpha;
        LDS_WAIT();
#pragma unroll
        for (int r = 0; r < 16; ++r) { const float a = al_l[crow(r, hi)];
#pragma unroll
            for (int d = 0; d < 4; ++d) o[d][r] *= a; }
        LDS_WAIT();
    }
}
struct KVStage { bf16x8 k0, k1, v0, v1; };
__device__ __forceinline__ void kv_load(KVStage& s, const bf16* Kp, const bf16* Vp, int ld, int kb0, int sr, int sc) {
    const bf16* kq = Kp + (size_t)kb0 * ld; const bf16* vq = Vp + (size_t)kb0 * ld;
    const unsigned o0 = (unsigned)(sr * ld + sc), o1 = o0 + 32u * (unsigned)ld;
    s.k0 = *(const GAS bf16x8*)(kq + o0); s.k1 = *(const GAS bf16x8*)(kq + o1);
    s.v0 = *(const GAS bf16x8*)(vq + o0); s.v1 = *(const GAS bf16x8*)(vq + o1);
}
__device__ __forceinline__ void kv_write(const KVStage& s, LAS char* K_lds, LAS char* V_lds, int sr, int sc) {
    const int kws = KSWZ(sr, sc * 2);
    *(LAS bf16x8*)(K_lds + kws) = s.k0; *(LAS bf16x8*)(K_lds + kws + 32 * 256) = s.k1;
    *(LAS bf16x8*)(V_lds + v_st(sr, sc)) = s.v0; *(LAS bf16x8*)(V_lds + v_st(32 + sr, sc)) = s.v1;
}

__device__ __forceinline__ void moba_unit(LAS char* lds, const bf16* PROJ, const bf16* KMEAN, bf16* AO, int b, int h, int own, float thrB, int tid) {
    const int wid = __builtin_amdgcn_readfirstlane(tid >> 6), lane = tid & 63, r32 = lane & 31, hi = lane >> 5;
    const bool late = wid >= 4;
    LAS float* al_l = (LAS float*)(lds + 6 * ATT_TILE) + wid * 64;
    const int sr = tid >> 4, sc = (tid & 15) * 8;
    const bf16* Kp = PROJ + (size_t)((1 * 64 + b * 16 + h) * T) * 128; const bf16* Vp = PROJ + (size_t)((2 * 64 + b * 16 + h) * T) * 128;
    const int tq = own * 256 + wid * 32 + r32;
    const float slope = exp2f(-0.5f * (float)(h + 1));
    int t_lo = 0; { const float lim = (float)(own * 256 - 63) - thrB / slope; if (lim > 0.f) t_lo = (int)ceilf(lim * (1.f / 64.f)); if (t_lo > 4 * own) t_lo = 4 * own; }
    t_lo = __builtin_amdgcn_readfirstlane(t_lo);
    const int NT = 4 * (own + 1) - t_lo;
    bf16x8 qr[8];
    { const bf16* qp = PROJ + ((size_t)((0 * 64 + b * 16 + h) * T) + tq) * 128 + hi * 8;
#pragma unroll
      for (int d0 = 0; d0 < 8; ++d0) qr[d0] = *(const GAS bf16x8*)(qp + d0 * 16); }
    KVStage st; kv_load(st, Kp, Vp, 128, t_lo * 64, sr, sc);
    __syncthreads();
    { const int row = tid >> 4, chk = tid & 15; bf16x8 v = {0, 0, 0, 0, 0, 0, 0, 0};
      if (row < 16) v = *(const GAS bf16x8*)(KMEAN + ((size_t)((b * 16 + h) * 16 + row)) * 128 + chk * 8);
      *(LAS bf16x8*)(lds + 5 * ATT_TILE + KSWZ(row, chk * 16)) = v; }
    kv_write(st, lds + ATT_TILE, lds, sr, sc);
    if (NT > 1) kv_load(st, Kp, Vp, 128, (t_lo + 1) * 64, sr, sc);
    __syncthreads();
    unsigned sel = 0u;
    { f32x16 g0; qkt32(g0, lds + 5 * ATT_TILE, r32, hi, qr);
      float gate[16];
#pragma unroll
      for (int k = 0; k < 8; ++k) { const int nA = (k & 3) + 8 * (k >> 2), nB = nA + 4; const float mine = g0[k], oth = pair_other(mine, hi);
          gate[nA] = hi ? oth : mine; gate[nB] = hi ? mine : oth; }
      if (own <= 3) sel = (1u << own) - 1u;
      else {
#pragma unroll
          for (int pick = 0; pick < 3; ++pick) { float best = -3.0e38f; int bi = 0;
#pragma unroll
              for (int n = 0; n < 16; ++n) { const bool ok = (n < own) && !((sel >> n) & 1u) && (gate[n] > best); best = ok ? gate[n] : best; bi = ok ? n : bi; }
              sel |= 1u << bi; } } }
    const float C2 = 0.08838834764831845f * 1.4426950408889634f, SL2 = slope * 1.4426950408889634f, SL8 = 8.f * SL2, SL32 = 32.f * SL2;
    const float NEG = -__builtin_inff();
    float m = -1e30f, l = 0.f; f32x16 o[4] = {};
    bf16x8 pa0 = {0, 0, 0, 0, 0, 0, 0, 0}, pa1 = pa0, pa2 = pa0, pa3 = pa0; bool pend = false; int vprev = 0;
    int cur = 0;
    for (int t = 0; t < NT; ++t) {
        const int tt = t_lo + t; const int nxt = cur == 2 ? 0 : cur + 1;
        LAS char* Vc = lds + cur * 2 * ATT_TILE; LAS char* Kc = Vc + ATT_TILE;
        if (t + 1 < NT) { kv_write(st, lds + nxt * 2 * ATT_TILE + ATT_TILE, lds + nxt * 2 * ATT_TILE, sr, sc);
            if (t + 2 < NT) kv_load(st, Kp, Vp, 128, (tt + 2) * 64, sr, sc); }
        if (late && pend) pv64(o, vprev, pa0, pa1, pa2, pa3);
        const int n = tt >> 2; const bool past = n < own;
        const bool mysel = (sel >> n) & 1u;
        const bool act = past ? (__ballot(mysel) != 0ull) : ((tt & 3) * 64 <= wid * 32 + 31);
        if (act) {
            f32x16 p0, p1; qkt64(p0, p1, Kc, r32, hi, qr);
            const int dq = tq - tt * 64 - 4 * hi;
            { float xq_ = (!past || mysel) ? -SL2 * (float)dq : NEG;
#pragma unroll
              for (int q = 0; q < 4; ++q) { float y = xq_;
#pragma unroll
                  for (int i = 0; i < 4; ++i) { const int r = 4 * q + i; p0[r] = fmaf(p0[r], C2, y); p1[r] = fmaf(p1[r], C2, y + SL32); y += SL2; }
                  xq_ += SL8; } }
            if (!past && (tt & 3) * 64 + 63 > wid * 32) {
#pragma unroll
                for (int r = 0; r < 16; ++r) { const int c = (r & 3) + 8 * (r >> 2); p0[r] = (dq >= c) ? p0[r] : NEG; p1[r] = (dq >= c + 32) ? p1[r] : NEG; } }
            softmax_step(p0, p1, m, l, o, al_l, r32, hi);
            pack_p(p0, p1, pa0, pa1, pa2, pa3);
            if (!late) pv64(o, (int)(unsigned)(uintptr_t)Vc + v_rd_base(lane), pa0, pa1, pa2, pa3);
        }
        pend = act; vprev = (int)(unsigned)(uintptr_t)Vc + v_rd_base(lane);
        cur = nxt;
        __syncthreads();
    }
    if (late && pend) pv64(o, vprev, pa0, pa1, pa2, pa3);
    if (hi == 0) al_l[r32] = l; LDS_WAIT();
    float rli[16];
#pragma unroll
    for (int r = 0; r < 16; ++r) rli[r] = 1.0f / al_l[crow(r, hi)];
    LDS_WAIT();
    store_o(o, rli, AO + (size_t)(b * T + own * 256 + wid * 32) * LDAO + h * 128, LDAO, r32, hi);
}

__device__ __forceinline__ void sb_unit(LAS char* lds, const bf16* PROJ, bf16* AO, int b, int h, int blk, int tid) {
    const int wid = __builtin_amdgcn_readfirstlane(tid >> 6), lane = tid & 63, r32 = lane & 31, hi = lane >> 5;
    LAS char* V_lds = lds; LAS char* K_lds = lds + ATT_TILE; LAS unsigned* flags = (LAS unsigned*)(lds + 2 * ATT_TILE + 2048);
    const int sr = tid >> 4, sc = (tid & 15) * 8;
    const bf16* Kp = PROJ + (size_t)((4 * 64 + b * 16 + h) * T) * 128; const bf16* Vp = PROJ + (size_t)((5 * 64 + b * 16 + h) * T) * 128;
    const int tq = blk * 256 + wid * 32 + r32;
    bf16x8 qr[8];
    { const bf16* qp = PROJ + ((size_t)((3 * 64 + b * 16 + h) * T) + tq) * 128 + hi * 8;
#pragma unroll
      for (int d0 = 0; d0 < 8; ++d0) qr[d0] = *(const GAS bf16x8*)(qp + d0 * 16); }
    int jt = blk * 4 + 3;
    KVStage st; kv_load(st, Kp, Vp, 128, jt * 64, sr, sc);
    float R = 1.f; f32x16 o[4] = {};
    const int vb0 = (int)(unsigned)(uintptr_t)V_lds + v_rd_base(lane);
    const float SL2E = 0.08838834764831845f * 1.4426950408889634f;
    bool wdone = false;
    for (;;) {
        __syncthreads();
        kv_write(st, K_lds, V_lds, sr, sc);
        __syncthreads();
        if (jt > 0) kv_load(st, Kp, Vp, 128, (jt - 1) * 64, sr, sc);
        const bool started = jt * 64 <= blk * 256 + wid * 32 + 30;
        if (started && !wdone) {
            const int dq = tq - jt * 64 - 4 * hi;
            const bool allpast = jt * 64 + 63 < blk * 256 + wid * 32;
            bf16x8 pa[4]; float acc = 1.f;
#pragma unroll
            for (int ph = 1; ph >= 0; --ph) {
                f32x16 z; qkt32(z, K_lds + ph * 32 * 256, r32, hi, qr);
                f32x16 om; const int dqh = dq - 32 * ph;
#pragma unroll
                for (int r = 0; r < 16; ++r) { const float om_ = __builtin_amdgcn_rcpf(1.0f + __builtin_amdgcn_exp2f(z[r] * SL2E)); om[r] = om_; z[r] = 1.0f - om_; }
                if (!allpast) {
#pragma unroll
                    for (int r = 0; r < 16; ++r) { const int c = (r & 3) + 8 * (r >> 2); const bool strict = dqh > c; om[r] = strict ? om[r] : 1.0f; z[r] = strict ? z[r] : 0.f; } }
#pragma unroll
                for (int q = 3; q >= 0; --q) { const float mine = (om[4 * q] * om[4 * q + 1]) * (om[4 * q + 2] * om[4 * q + 3]);
                    unsigned a_, b_; pair_get(__float_as_uint(mine), a_, b_); const float s_lo = __uint_as_float(a_), s_hi = __uint_as_float(b_);
                    const float bs = R * (hi ? acc : (acc * s_hi)); acc *= s_hi * s_lo;
                    const float e3 = bs, e2 = bs * om[4 * q + 3], e1 = e2 * om[4 * q + 2], e0 = e1 * om[4 * q + 1];
                    z[4 * q + 0] *= e0; z[4 * q + 1] *= e1; z[4 * q + 2] *= e2; z[4 * q + 3] *= e3; }
#define PK4(P, B_, OUT) do { unsigned a0 = cvtpk(P[B_+0], P[B_+1]), a1 = cvtpk(P[B_+2], P[B_+3]);                          \
        unsigned b0 = cvtpk(P[B_+4], P[B_+5]), b1 = cvtpk(P[B_+6], P[B_+7]);                                             \
        auto r0 = __builtin_amdgcn_permlane32_swap(a0, b0, false, false); auto r1 = __builtin_amdgcn_permlane32_swap(a1, b1, false, false); \
        v4u w = {r0[0], r1[0], r0[1], r1[1]}; OUT = __builtin_bit_cast(bf16x8, w); } while (0)
                PK4(z, 0, pa[2 * ph]); PK4(z, 8, pa[2 * ph + 1]);
#undef PK4
            }
            R *= acc;
            pv64(o, vb0, pa[0], pa[1], pa[2], pa[3]);
            wdone = __all(R < 1e-36f);
        }
        if (lane == 0) flags[wid] = wdone ? 1u : 0u;
        __syncthreads();
        bool alld = true;
#pragma unroll
        for (int w = 0; w < 8; ++w) alld = alld && (flags[w] != 0u);
        if (jt == 0 || alld) break;
        --jt;
    }
    float one[16];
#pragma unroll
    for (int r = 0; r < 16; ++r) one[r] = 1.0f;
    store_o(o, one, AO + (size_t)(b * T + blk * 256 + wid * 32) * LDAO + 2048 + h * 128, LDAO, r32, hi);
}

__device__ __forceinline__ void xattn_unit(LAS char* lds, const bf16* XQ, const bf16* KVMEM, const float* gq, const float* gk, bf16* XO, int b, int xh, int blk, int tid) {
    const int wid = __builtin_amdgcn_readfirstlane(tid >> 6), lane = tid & 63, r32 = lane & 31, hi = lane >> 5;
    LAS char* V_lds = lds; LAS char* K_lds = lds + ATT_TILE; LAS float* al_l = (LAS float*)(lds + 2 * ATT_TILE) + wid * 64;
    const int sr = tid >> 4, sc = (tid & 15) * 8;
    const bf16* Kp = KVMEM + (size_t)(b * NMEM) * 1024 + xh * 128; const bf16* Vp = KVMEM + (size_t)(b * NMEM) * 1024 + 512 + xh * 128;
    const int row = b * T + blk * 256 + wid * 32 + r32;
    bf16x8 qr[8];
    { const bf16* qp = XQ + (size_t)row * XW + xh * 128 + hi * 8;
      v4u raw[8]; float ss = 0.f;
#pragma unroll
      for (int d0 = 0; d0 < 8; ++d0) { raw[d0] = *(const GAS v4u*)(qp + d0 * 16);
          const float x[8] = {bflo(raw[d0].x), bfhi(raw[d0].x), bflo(raw[d0].y), bfhi(raw[d0].y), bflo(raw[d0].z), bfhi(raw[d0].z), bflo(raw[d0].w), bfhi(raw[d0].w)};
#pragma unroll
          for (int k = 0; k < 8; ++k) ss += x[k] * x[k]; }
      ss = pair_sum(ss);
      const float r = 1.0f / sqrtf(ss * (1.f / 128.f) + RMS_EPS);
#pragma unroll
      for (int d0 = 0; d0 < 8; ++d0) { const float* g = gq + d0 * 16 + hi * 8; const f32x4 ga = *(const GAS f32x4*)g, gb = *(const GAS f32x4*)(g + 4);
          v4u w; w.x = pk2(bflo(raw[d0].x) * r * ga.x, bfhi(raw[d0].x) * r * ga.y); w.y = pk2(bflo(raw[d0].y) * r * ga.z, bfhi(raw[d0].y) * r * ga.w);
          w.z = pk2(bflo(raw[d0].z) * r * gb.x, bfhi(raw[d0].z) * r * gb.y); w.w = pk2(bflo(raw[d0].w) * r * gb.z, bfhi(raw[d0].w) * r * gb.w);
          qr[d0] = __builtin_bit_cast(bf16x8, w); } }
    float gkk[8];
#pragma unroll
    for (int j = 0; j < 8; ++j) gkk[j] = gk[sc + j];
    const float C2 = 0.08838834764831845f * 1.4426950408889634f;
    float m = -1e30f, l = 0.f; f32x16 o[4] = {};
    const int vb0 = (int)(unsigned)(uintptr_t)V_lds + v_rd_base(lane);
    KVStage st; kv_load(st, Kp, Vp, 1024, 0, sr, sc);
    for (int t = 0; t < 4; ++t) {
        { v4u w0 = __builtin_bit_cast(v4u, st.k0), w1 = __builtin_bit_cast(v4u, st.k1);
          float x0[8] = {bflo(w0.x), bfhi(w0.x), bflo(w0.y), bfhi(w0.y), bflo(w0.z), bfhi(w0.z), bflo(w0.w), bfhi(w0.w)};
          float x1[8] = {bflo(w1.x), bfhi(w1.x), bflo(w1.y), bfhi(w1.y), bflo(w1.z), bfhi(w1.z), bflo(w1.w), bfhi(w1.w)};
          float s0 = 0.f, s1 = 0.f;
#pragma unroll
          for (int k = 0; k < 8; ++k) { s0 += x0[k] * x0[k]; s1 += x1[k] * x1[k]; }
          s0 += __shfl_xor(s0, 1); s0 += __shfl_xor(s0, 2); s0 += __shfl_xor(s0, 4); s0 += __shfl_xor(s0, 8);
          s1 += __shfl_xor(s1, 1); s1 += __shfl_xor(s1, 2); s1 += __shfl_xor(s1, 4); s1 += __shfl_xor(s1, 8);
          const float r0 = 1.0f / sqrtf(s0 * (1.f / 128.f) + RMS_EPS), r1 = 1.0f / sqrtf(s1 * (1.f / 128.f) + RMS_EPS);
          w0.x = pk2(x0[0] * r0 * gkk[0], x0[1] * r0 * gkk[1]); w0.y = pk2(x0[2] * r0 * gkk[2], x0[3] * r0 * gkk[3]); w0.z = pk2(x0[4] * r0 * gkk[4], x0[5] * r0 * gkk[5]); w0.w = pk2(x0[6] * r0 * gkk[6], x0[7] * r0 * gkk[7]);
          w1.x = pk2(x1[0] * r1 * gkk[0], x1[1] * r1 * gkk[1]); w1.y = pk2(x1[2] * r1 * gkk[2], x1[3] * r1 * gkk[3]); w1.z = pk2(x1[4] * r1 * gkk[4], x1[5] * r1 * gkk[5]); w1.w = pk2(x1[6] * r1 * gkk[6], x1[7] * r1 * gkk[7]);
          st.k0 = __builtin_bit_cast(bf16x8, w0); st.k1 = __builtin_bit_cast(bf16x8, w1); }
        __syncthreads();
        kv_write(st, K_lds, V_lds, sr, sc);
        __syncthreads();
        if (t + 1 < 4) kv_load(st, Kp, Vp, 1024, (t + 1) * 64, sr, sc);
        f32x16 p0, p1; qkt64(p0, p1, K_lds, r32, hi, qr);
#pragma unroll
        for (int r = 0; r < 16; ++r) { p0[r] *= C2; p1[r] *= C2; }
        softmax_step(p0, p1, m, l, o, al_l, r32, hi);
        bf16x8 pa0, pa1, pa2, pa3; pack_p(p0, p1, pa0, pa1, pa2, pa3);
        pv64(o, vb0, pa0, pa1, pa2, pa3);
    }
    if (hi == 0) al_l[r32] = l; LDS_WAIT();
    float rli[16];
#pragma unroll
    for (int r = 0; r < 16; ++r) rli[r] = 1.0f / al_l[crow(r, hi)];
    LDS_WAIT();
    store_o(o, rli, XO + (size_t)(b * T + blk * 256 + wid * 32) * LDXO + xh * 128, LDXO, r32, hi);
    __syncthreads();
}

__device__ __forceinline__ unsigned f2ord(float f) { const unsigned u = __float_as_uint(f); return u ^ ((u >> 31) ? 0xffffffffu : 0x80000000u); }
__device__ __forceinline__ float ord2f(unsigned k) { return __uint_as_float(k ^ ((k >> 31) ? 0x80000000u : 0xffffffffu)); }
__device__ __forceinline__ void sort16_desc(unsigned (&x)[16]) {
    { const unsigned hi_ = x[0] > x[1] ? x[0] : x[1], lo_ = x[0] > x[1] ? x[1] : x[0]; x[0] = hi_; x[1] = lo_; }
    { const unsigned hi_ = x[2] > x[3] ? x[2] : x[3], lo_ = x[2] > x[3] ? x[3] : x[2]; x[2] = lo_; x[3] = hi_; }
    { const unsigned hi_ = x[4] > x[5] ? x[4] : x[5], lo_ = x[4] > x[5] ? x[5] : x[4]; x[4] = hi_; x[5] = lo_; }
    { const unsigned hi_ = x[6] > x[7] ? x[6] : x[7], lo_ = x[6] > x[7] ? x[7] : x[6]; x[6] = lo_; x[7] = hi_; }
    { const unsigned hi_ = x[8] > x[9] ? x[8] : x[9], lo_ = x[8] > x[9] ? x[9] : x[8]; x[8] = hi_; x[9] = lo_; }
    { const unsigned hi_ = x[10] > x[11] ? x[10] : x[11], lo_ = x[10] > x[11] ? x[11] : x[10]; x[10] = lo_; x[11] = hi_; }
    { const unsigned hi_ = x[12] > x[13] ? x[12] : x[13], lo_ = x[12] > x[13] ? x[13] : x[12]; x[12] = hi_; x[13] = lo_; }
    { const unsigned hi_ = x[14] > x[15] ? x[14] : x[15], lo_ = x[14] > x[15] ? x[15] : x[14]; x[14] = lo_; x[15] = hi_; }
    { const unsigned hi_ = x[0] > x[2] ? x[0] : x[2], lo_ = x[0] > x[2] ? x[2] : x[0]; x[0] = hi_; x[2] = lo_; }
    { const unsigned hi_ = x[1] > x[3] ? x[1] : x[3], lo_ = x[1] > x[3] ? x[3] : x[1]; x[1] = hi_; x[3] = lo_; }
    { const unsigned hi_ = x[4] > x[6] ? x[4] : x[6], lo_ = x[4] > x[6] ? x[6] : x[4]; x[4] = lo_; x[6] = hi_; }
    { const unsigned hi_ = x[5] > x[7] ? x[5] : x[7], lo_ = x[5] > x[7] ? x[7] : x[5]; x[5] = lo_; x[7] = hi_; }
    { const unsigned hi_ = x[8] > x[10] ? x[8] : x[10], lo_ = x[8] > x[10] ? x[10] : x[8]; x[8] = hi_; x[10] = lo_; }
    { const unsigned hi_ = x[9] > x[11] ? x[9] : x[11], lo_ = x[9] > x[11] ? x[11] : x[9]; x[9] = hi_; x[11] = lo_; }
    { const unsigned hi_ = x[12] > x[14] ? x[12] : x[14], lo_ = x[12] > x[14] ? x[14] : x[12]; x[12] = lo_; x[14] = hi_; }
    { const unsigned hi_ = x[13] > x[15] ? x[13] : x[15], lo_ = x[13] > x[15] ? x[15] : x[13]; x[13] = lo_; x[15] = hi_; }
    { const unsigned hi_ = x[0] > x[1] ? x[0] : x[1], lo_ = x[0] > x[1] ? x[1] : x[0]; x[0] = hi_; x[1] = lo_; }
    { const unsigned hi_ = x[2] > x[3] ? x[2] : x[3], lo_ = x[2] > x[3] ? x[3] : x[2]; x[2] = hi_; x[3] = lo_; }
    { const unsigned hi_ = x[4] > x[5] ? x[4] : x[5], lo_ = x[4] > x[5] ? x[5] : x[4]; x[4] = lo_; x[5] = hi_; }
    { const unsigned hi_ = x[6] > x[7] ? x[6] : x[7], lo_ = x[6] > x[7] ? x[7] : x[6]; x[6] = lo_; x[7] = hi_; }
    { const unsigned hi_ = x[8] > x[9] ? x[8] : x[9], lo_ = x[8] > x[9] ? x[9] : x[8]; x[8] = hi_; x[9] = lo_; }
    { const unsigned hi_ = x[10] > x[11] ? x[10] : x[11], lo_ = x[10] > x[11] ? x[11] : x[10]; x[10] = hi_; x[11] = lo_; }
    { const unsigned hi_ = x[12] > x[13] ? x[12] : x[13], lo_ = x[12] > x[13] ? x[13] : x[12]; x[12] = lo_; x[13] = hi_; }
    { const unsigned hi_ = x[14] > x[15] ? x[14] : x[15], lo_ = x[14] > x[15] ? x[15] : x[14]; x[14] = lo_; x[15] = hi_; }
    { const unsigned hi_ = x[0] > x[4] ? x[0] : x[4], lo_ = x[0] > x[4] ? x[4] : x[0]; x[0] = hi_; x[4] = lo_; }
    { const unsigned hi_ = x[1] > x[5] ? x[1] : x[5], lo_ = x[1] > x[5] ? x[5] : x[1]; x[1] = hi_; x[5] = lo_; }
    { const unsigned hi_ = x[2] > x[6] ? x[2] : x[6], lo_ = x[2] > x[6] ? x[6] : x[2]; x[2] = hi_; x[6] = lo_; }
    { const unsigned hi_ = x[3] > x[7] ? x[3] : x[7], lo_ = x[3] > x[7] ? x[7] : x[3]; x[3] = hi_; x[7] = lo_; }
    { const unsigned hi_ = x[8] > x[12] ? x[8] : x[12], lo_ = x[8] > x[12] ? x[12] : x[8]; x[8] = lo_; x[12] = hi_; }
    { const unsigned hi_ = x[9] > x[13] ? x[9] : x[13], lo_ = x[9] > x[13] ? x[13] : x[9]; x[9] = lo_; x[13] = hi_; }
    { const unsigned hi_ = x[10] > x[14] ? x[10] : x[14], lo_ = x[10] > x[14] ? x[14] : x[10]; x[10] = lo_; x[14] = hi_; }
    { const unsigned hi_ = x[11] > x[15] ? x[11] : x[15], lo_ = x[11] > x[15] ? x[15] : x[11]; x[11] = lo_; x[15] = hi_; }
    { const unsigned hi_ = x[0] > x[2] ? x[0] : x[2], lo_ = x[0] > x[2] ? x[2] : x[0]; x[0] = hi_; x[2] = lo_; }
    { const unsigned hi_ = x[1] > x[3] ? x[1] : x[3], lo_ = x[1] > x[3] ? x[3] : x[1]; x[1] = hi_; x[3] = lo_; }
    { const unsigned hi_ = x[4] > x[6] ? x[4] : x[6], lo_ = x[4] > x[6] ? x[6] : x[4]; x[4] = hi_; x[6] = lo_; }
    { const unsigned hi_ = x[5] > x[7] ? x[5] : x[7], lo_ = x[5] > x[7] ? x[7] : x[5]; x[5] = hi_; x[7] = lo_; }
    { const unsigned hi_ = x[8] > x[10] ? x[8] : x[10], lo_ = x[8] > x[10] ? x[10] : x[8]; x[8] = lo_; x[10] = hi_; }
    { const unsigned hi_ = x[9] > x[11] ? x[9] : x[11], lo_ = x[9] > x[11] ? x[11] : x[9]; x[9] = lo_; x[11] = hi_; }
    { const unsigned hi_ = x[12] > x[14] ? x[12] : x[14], lo_ = x[12] > x[14] ? x[14] : x[12]; x[12] = lo_; x[14] = hi_; }
    { const unsigned hi_ = x[13] > x[15] ? x[13] : x[15], lo_ = x[13] > x[15] ? x[15] : x[13]; x[13] = lo_; x[15] = hi_; }
    { const unsigned hi_ = x[0] > x[1] ? x[0] : x[1], lo_ = x[0] > x[1] ? x[1] : x[0]; x[0] = hi_; x[1] = lo_; }
    { const unsigned hi_ = x[2] > x[3] ? x[2] : x[3], lo_ = x[2] > x[3] ? x[3] : x[2]; x[2] = hi_; x[3] = lo_; }
    { const unsigned hi_ = x[4] > x[5] ? x[4] : x[5], lo_ = x[4] > x[5] ? x[5] : x[4]; x[4] = hi_; x[5] = lo_; }
    { const unsigned hi_ = x[6] > x[7] ? x[6] : x[7], lo_ = x[6] > x[7] ? x[7] : x[6]; x[6] = hi_; x[7] = lo_; }
    { const unsigned hi_ = x[8] > x[9] ? x[8] : x[9], lo_ = x[8] > x[9] ? x[9] : x[8]; x[8] = lo_; x[9] = hi_; }
    { const unsigned hi_ = x[10] > x[11] ? x[10] : x[11], lo_ = x[10] > x[11] ? x[11] : x[10]; x[10] = lo_; x[11] = hi_; }
    { const unsigned hi_ = x[12] > x[13] ? x[12] : x[13], lo_ = x[12] > x[13] ? x[13] : x[12]; x[12] = lo_; x[13] = hi_; }
    { const unsigned hi_ = x[14] > x[15] ? x[14] : x[15], lo_ = x[14] > x[15] ? x[15] : x[14]; x[14] = lo_; x[15] = hi_; }
    { const unsigned hi_ = x[0] > x[8] ? x[0] : x[8], lo_ = x[0] > x[8] ? x[8] : x[0]; x[0] = hi_; x[8] = lo_; }
    { const unsigned hi_ = x[1] > x[9] ? x[1] : x[9], lo_ = x[1] > x[9] ? x[9] : x[1]; x[1] = hi_; x[9] = lo_; }
    { const unsigned hi_ = x[2] > x[10] ? x[2] : x[10], lo_ = x[2] > x[10] ? x[10] : x[2]; x[2] = hi_; x[10] = lo_; }
    { const unsigned hi_ = x[3] > x[11] ? x[3] : x[11], lo_ = x[3] > x[11] ? x[11] : x[3]; x[3] = hi_; x[11] = lo_; }
    { const unsigned hi_ = x[4] > x[12] ? x[4] : x[12], lo_ = x[4] > x[12] ? x[12] : x[4]; x[4] = hi_; x[12] = lo_; }
    { const unsigned hi_ = x[5] > x[13] ? x[5] : x[13], lo_ = x[5] > x[13] ? x[13] : x[5]; x[5] = hi_; x[13] = lo_; }
    { const unsigned hi_ = x[6] > x[14] ? x[6] : x[14], lo_ = x[6] > x[14] ? x[14] : x[6]; x[6] = hi_; x[14] = lo_; }
    { const unsigned hi_ = x[7] > x[15] ? x[7] : x[15], lo_ = x[7] > x[15] ? x[15] : x[7]; x[7] = hi_; x[15] = lo_; }
    { const unsigned hi_ = x[0] > x[4] ? x[0] : x[4], lo_ = x[0] > x[4] ? x[4] : x[0]; x[0] = hi_; x[4] = lo_; }
    { const unsigned hi_ = x[1] > x[5] ? x[1] : x[5], lo_ = x[1] > x[5] ? x[5] : x[1]; x[1] = hi_; x[5] = lo_; }
    { const unsigned hi_ = x[2] > x[6] ? x[2] : x[6], lo_ = x[2] > x[6] ? x[6] : x[2]; x[2] = hi_; x[6] = lo_; }
    { const unsigned hi_ = x[3] > x[7] ? x[3] : x[7], lo_ = x[3] > x[7] ? x[7] : x[3]; x[3] = hi_; x[7] = lo_; }
    { const unsigned hi_ = x[8] > x[12] ? x[8] : x[12], lo_ = x[8] > x[12] ? x[12] : x[8]; x[8] = hi_; x[12] = lo_; }
    { const unsigned hi_ = x[9] > x[13] ? x[9] : x[13], lo_ = x[9] > x[13] ? x[13] : x[9]; x[9] = hi_; x[13] = lo_; }
    { const unsigned hi_ = x[10] > x[14] ? x[10] : x[14], lo_ = x[10] > x[14] ? x[14] : x[10]; x[10] = hi_; x[14] = lo_; }
    { const unsigned hi_ = x[11] > x[15] ? x[11] : x[15], lo_ = x[11] > x[15] ? x[15] : x[11]; x[11] = hi_; x[15] = lo_; }
    { const unsigned hi_ = x[0] > x[2] ? x[0] : x[2], lo_ = x[0] > x[2] ? x[2] : x[0]; x[0] = hi_; x[2] = lo_; }
    { const unsigned hi_ = x[1] > x[3] ? x[1] : x[3], lo_ = x[1] > x[3] ? x[3] : x[1]; x[1] = hi_; x[3] = lo_; }
    { const unsigned hi_ = x[4] > x[6] ? x[4] : x[6], lo_ = x[4] > x[6] ? x[6] : x[4]; x[4] = hi_; x[6] = lo_; }
    { const unsigned hi_ = x[5] > x[7] ? x[5] : x[7], lo_ = x[5] > x[7] ? x[7] : x[5]; x[5] = hi_; x[7] = lo_; }
    { const unsigned hi_ = x[8] > x[10] ? x[8] : x[10], lo_ = x[8] > x[10] ? x[10] : x[8]; x[8] = hi_; x[10] = lo_; }
    { const unsigned hi_ = x[9] > x[11] ? x[9] : x[11], lo_ = x[9] > x[11] ? x[11] : x[9]; x[9] = hi_; x[11] = lo_; }
    { const unsigned hi_ = x[12] > x[14] ? x[12] : x[14], lo_ = x[12] > x[14] ? x[14] : x[12]; x[12] = hi_; x[14] = lo_; }
    { const unsigned hi_ = x[13] > x[15] ? x[13] : x[15], lo_ = x[13] > x[15] ? x[15] : x[13]; x[13] = hi_; x[15] = lo_; }
    { const unsigned hi_ = x[0] > x[1] ? x[0] : x[1], lo_ = x[0] > x[1] ? x[1] : x[0]; x[0] = hi_; x[1] = lo_; }
    { const unsigned hi_ = x[2] > x[3] ? x[2] : x[3], lo_ = x[2] > x[3] ? x[3] : x[2]; x[2] = hi_; x[3] = lo_; }
    { const unsigned hi_ = x[4] > x[5] ? x[4] : x[5], lo_ = x[4] > x[5] ? x[5] : x[4]; x[4] = hi_; x[5] = lo_; }
    { const unsigned hi_ = x[6] > x[7] ? x[6] : x[7], lo_ = x[6] > x[7] ? x[7] : x[6]; x[6] = hi_; x[7] = lo_; }
    { const unsigned hi_ = x[8] > x[9] ? x[8] : x[9], lo_ = x[8] > x[9] ? x[9] : x[8]; x[8] = hi_; x[9] = lo_; }
    { const unsigned hi_ = x[10] > x[11] ? x[10] : x[11], lo_ = x[10] > x[11] ? x[11] : x[10]; x[10] = hi_; x[11] = lo_; }
    { const unsigned hi_ = x[12] > x[13] ? x[12] : x[13], lo_ = x[12] > x[13] ? x[13] : x[12]; x[12] = hi_; x[13] = lo_; }
    { const unsigned hi_ = x[14] > x[15] ? x[14] : x[15], lo_ = x[14] > x[15] ? x[15] : x[14]; x[14] = hi_; x[15] = lo_; }
}
__device__ __forceinline__ void bmerge16_desc(unsigned (&a)[16]) {
#pragma unroll
    for (int st = 8; st >= 1; st >>= 1)
#pragma unroll
        for (int i = 0; i < 16; ++i) if ((i & st) == 0) { const unsigned hi_ = a[i] > a[i + st] ? a[i] : a[i + st], lo_ = a[i] > a[i + st] ? a[i + st] : a[i]; a[i] = hi_; a[i + st] = lo_; }
}
__device__ __forceinline__ void merge16_desc(unsigned (&a)[16], const unsigned (&b)[16]) {
#pragma unroll
    for (int i = 0; i < 16; ++i) a[i] = a[i] > b[15 - i] ? a[i] : b[15 - i];
    bmerge16_desc(a);
}
__device__ __forceinline__ void peer_route_unit(LAS char* lds, const bf16* PQ, const bf16* SUBK, unsigned char* G8, int tile32, int tid) {
    const int wid = __builtin_amdgcn_readfirstlane(tid >> 6), lane = tid & 63, r32 = lane & 31, hi = lane >> 5, hp = wid;
    LAS unsigned* lists = (LAS unsigned*)lds + wid * 1024;
    LAS v2u* ENT = (LAS v2u*)(lds + 40960);
    __syncthreads();
    { LAS v4u* hz = (LAS v4u*)(lds + 73728) + tid * 2; hz[0] = (v4u){0u, 0u, 0u, 0u}; hz[1] = (v4u){0u, 0u, 0u, 0u}; if (tid == 0) *(LAS unsigned*)(lds + 106496) = 0u; }
    const int token = tile32 * 32 + r32;
#pragma unroll 1
    for (int half = 0; half < 2; ++half) {
        bf16x8 qr[8];
        { const bf16* qp = PQ + (size_t)token * PQW + hp * 256 + half * 128 + hi * 8;
#pragma unroll
          for (int d0 = 0; d0 < 8; ++d0) qr[d0] = *(const GAS bf16x8*)(qp + d0 * 16); }
        unsigned key[4][16]; unsigned hi4 = (unsigned)hi << 2; asm volatile("" : "+v"(hi4));
        const bf16* kt0 = SUBK + ((size_t)((hp * 2 + half) * 128 + r32)) * 128 + hi * 8;
        bf16x8 fa[8];
#pragma unroll
        for (int d0 = 0; d0 < 8; ++d0) fa[d0] = *(const GAS bf16x8*)(kt0 + d0 * 16);
#pragma unroll
        for (int kg = 0; kg < 4; ++kg) { f32x16 s = f32x16{}; bf16x8 fb[8];
            if (kg < 3) {
#pragma unroll
                for (int d0 = 0; d0 < 8; ++d0) fb[d0] = *(const GAS bf16x8*)(kt0 + (size_t)(kg + 1) * 32 * 128 + d0 * 16); }
#pragma unroll
            for (int d0 = 0; d0 < 8; ++d0) s = __builtin_amdgcn_mfma_f32_32x32x16_bf16(fa[d0], qr[d0], s, 0, 0, 0);
#pragma unroll
            for (int r = 0; r < 16; ++r) { const int kidx = kg * 32 + (r & 3) + 8 * (r >> 2);
                key[kg][r] = ((f2ord(s[r]) & ~127u) | (unsigned)(127 - kidx)) ^ hi4; }
            sort16_desc(key[kg]);
            SBAR();
            if (kg < 3) {
#pragma unroll
                for (int d0 = 0; d0 < 8; ++d0) fa[d0] = fb[d0]; } }
        merge16_desc(key[0], key[1]); merge16_desc(key[2], key[3]); merge16_desc(key[0], key[2]);
        { unsigned po[16];
#pragma unroll
          for (int i = 0; i < 16; ++i) { unsigned v0, v1; pair_get(key[0][i], v0, v1); po[i] = hi ? v0 : v1; }
          merge16_desc(key[0], po); }
        if (hi == 0) { LAS v4u* lst = (LAS v4u*)(lists + (half * 32 + r32) * 16);
#pragma unroll
            for (int i = 0; i < 4; ++i) lst[i] = (v4u){key[0][4 * i], key[0][4 * i + 1], key[0][4 * i + 2], key[0][4 * i + 3]}; }
    }
    LDS_WAIT();
    unsigned ka[16], kb[16];
    { const LAS unsigned* la = lists + (0 * 32 + r32) * 16; const LAS unsigned* lb = lists + (1 * 32 + r32) * 16;
#pragma unroll
      for (int i = 0; i < 16; ++i) { ka[i] = la[i]; kb[i] = lb[i]; } }
    LDS_WAIT();
    float va[16], vb[16];
#pragma unroll
    for (int i = 0; i < 16; ++i) { va[i] = ord2f(ka[i] & ~127u); vb[i] = ord2f(kb[i] & ~127u); }
#define CK(i, j) ((f2ord(va[i] + vb[j]) & ~255u) | (unsigned)(((15 - (i)) << 4) | (15 - (j))))
    unsigned WA[16], WB[16], WC[16], WD[16];
#pragma unroll
    for (int j = 0; j < 16; ++j) WA[j] = CK(0, j);
#pragma unroll
    for (int j = 0; j < 8; ++j) { WB[j] = CK(1, j); WB[8 + j] = CK(15 - j, 0); }
    WC[0] = CK(2, 0); WC[1] = CK(2, 1); WC[2] = CK(2, 2); WC[3] = CK(2, 3); WC[4] = CK(2, 4); WC[5] = 0u; WC[6] = 0u; WC[7] = 0u; WC[8] = 0u; WC[9] = 0u; WC[10] = 0u; WC[11] = 0u;
    WC[12] = CK(3, 3); WC[13] = CK(3, 2); WC[14] = CK(3, 1); WC[15] = CK(3, 0);
    WD[0] = CK(4, 0); WD[1] = CK(4, 1); WD[2] = CK(4, 2); WD[3] = CK(5, 0); WD[4] = CK(5, 1); WD[5] = CK(6, 0); WD[6] = CK(6, 1); WD[7] = CK(7, 0); WD[8] = CK(7, 1);
    WD[9] = 0u; WD[10] = 0u; WD[11] = 0u; WD[12] = 0u; WD[13] = 0u; WD[14] = 0u; WD[15] = 0u;
#undef CK
    bmerge16_desc(WB); bmerge16_desc(WC); sort16_desc(WD);
    merge16_desc(WC, WD); merge16_desc(WA, WB); merge16_desc(WA, WC);
    v2u ent[8]; float sv[8]; float smax = -3.0e38f;
    { const LAS unsigned* la = lists + (0 * 32 + r32) * 16; const LAS unsigned* lb = lists + (1 * 32 + r32) * 16;
#pragma unroll
      for (int k = 0; k < 8; ++k) { unsigned w0 = WA[k], w1 = WA[8 + k]; asm volatile("" : "+v"(w0), "+v"(w1));
          const unsigned w = hi ? w1 : w0; const unsigned ua = la[15 - ((w >> 4) & 15u)], ub = lb[15 - (w & 15u)];
          sv[k] = ord2f(ua & ~127u) + ord2f(ub & ~127u); ent[k].y = (127u - (ua & 127u)) * 128u + (127u - (ub & 127u)); smax = fmaxf(smax, sv[k]); } }
    smax = pair_max(smax);
    float wsum = 0.f;
#pragma unroll
    for (int k = 0; k < 8; ++k) { sv[k] = __builtin_amdgcn_exp2f((sv[k] - smax) * 1.4426950408889634f); wsum += sv[k]; }
    wsum = pair_sum(wsum);
    const float rinv = 1.0f / wsum;
#pragma unroll
    for (int k = 0; k < 8; ++k) { v2u e; e.x = ent[k].y; e.y = __float_as_uint(sv[k] * rinv); ENT[r32 * 128 + hp * 16 + 8 * hi + k] = e; }
    __syncthreads();
    { const int tk = tid >> 4, s = tid & 15; const LAS v2u* row = ENT + tk * 128;
      LAS unsigned* H1 = (LAS unsigned*)(lds + 73728) + tk * 64; LAS unsigned* H2 = H1 + 2048; LAS unsigned* WL = (LAS unsigned*)(lds + 90112); LAS unsigned* wcnt = (LAS unsigned*)(lds + 106496);
      unsigned myid[8]; float myw[8]; unsigned hb[8];
#pragma unroll
      for (int k = 0; k < 8; ++k) { const v2u e = row[s * 8 + k]; myid[k] = e.x; myw[k] = __uint_as_float(e.y); hb[k] = (e.x ^ (e.x >> 11)) & 2047u;
          const unsigned bit = 1u << (hb[k] & 31u); const unsigned old = __hip_atomic_fetch_or(H1 + (hb[k] >> 5), bit, __ATOMIC_RELAXED, __HIP_MEMORY_SCOPE_WORKGROUP);
          if (old & bit) __hip_atomic_fetch_or(H2 + (hb[k] >> 5), bit, __ATOMIC_RELAXED, __HIP_MEMORY_SCOPE_WORKGROUP); }
      __syncthreads();
      unsigned char* Grow = G8 + (size_t)(tile32 * 32 + tk) * LDG8;
#pragma unroll
      for (int k = 0; k < 8; ++k) { const bool shared = (H2[hb[k] >> 5] >> (hb[k] & 31u)) & 1u;
          if (!shared) Grow[myid[k]] = (unsigned char)(pk4_fp8(myw[k] * G_SCL, 0.f, 0.f, 0.f) & 0xffu);
          else { const unsigned w = __hip_atomic_fetch_add(wcnt, 1u, __ATOMIC_RELAXED, __HIP_MEMORY_SCOPE_WORKGROUP); WL[w] = (unsigned)(tk * 128 + s * 8 + k); } }
      __syncthreads();
      const unsigned nw = *wcnt;
      for (unsigned w = (unsigned)tid; w < nw; w += NWAVES * 64) { const unsigned e0 = WL[w]; const int tk2 = (int)(e0 >> 7), o0 = (int)(e0 & 127u); const LAS v2u* row2 = ENT + tk2 * 128;
          const unsigned id = row2[o0].x; float gs = 0.f; int fo = 127;
#pragma unroll 8
          for (int o = 0; o < 128; ++o) { const v2u e = row2[o]; const bool mt = e.x == id; gs += mt ? __uint_as_float(e.y) : 0.f; fo = mt ? (o < fo ? o : fo) : fo; }
          if (fo == o0) G8[(size_t)(tile32 * 32 + tk2) * LDG8 + id] = (unsigned char)(pk4_fp8(gs * G_SCL, 0.f, 0.f, 0.f) & 0xffu); } }
}

struct Args { const float* in[21]; float* out; unsigned char* ws; };
enum { I_X = 0, I_MEM, I_NORM_MIX_G, I_W_IN, I_MOBA_QG, I_MOBA_KG, I_MOBA_OG, I_SB_OG, I_W_OUT, I_NORM_XG, I_NORM_MEMG, I_W_XQ, I_W_XKV, I_XQG, I_XKG, I_W_XO, I_NORM_FG, I_W_PQ, I_SUBK, I_U, I_V };

__global__ void __launch_bounds__(NWAVES * 64, 2) mk_fwd(Args args) {
    extern __shared__ __attribute__((aligned(16))) unsigned char lds_raw[];
    LAS unsigned char* lds = (LAS unsigned char*)lds_raw;
    volatile LAS unsigned* MISC = (volatile LAS unsigned*)(lds + MISC_OFF);
    const int tid = threadIdx.x, lane = tid & 63, wave = __builtin_amdgcn_readfirstlane(tid >> 6);
    const int G = gridDim.x, bx = blockIdx.x;
    unsigned* ctl = (unsigned*)(args.ws + WS_CTL);
    for (int u = tid; u < (LDS_BYTES - RING_BYTES) / 4; u += NWAVES * 64) ((LAS unsigned*)(lds + RING_BYTES))[u] = 0u;
    __syncthreads();
    XcdBarrier bar = xcd_barrier_post(ctl + CW_BAR, MISC + 8);

    if (tid == 0) {
#pragma unroll
        for (int i = 0; i < 21; ++i) { const unsigned long long p = (unsigned long long)args.in[i]; MISC[16 + 2 * i] = (unsigned)p; MISC[17 + 2 * i] = (unsigned)(p >> 32); }
        { const unsigned long long p = (unsigned long long)args.out; MISC[16 + 42] = (unsigned)p; MISC[17 + 42] = (unsigned)(p >> 32); }
        { const unsigned long long p = (unsigned long long)args.ws; MISC[16 + 44] = (unsigned)p; MISC[17 + 44] = (unsigned)(p >> 32); }
    }
    __syncthreads();
#define PTR(i) ((const float*)(((unsigned long long)(unsigned)__builtin_amdgcn_readfirstlane((int)MISC[17 + 2 * (i)]) << 32) | (unsigned long long)(unsigned)__builtin_amdgcn_readfirstlane((int)MISC[16 + 2 * (i)])))
#define OUTP ((float*)PTR(21))
#define WSP(off) ((bf16*)((unsigned char*)PTR(22) + (off)))
#define GW (bx * NWAVES + wave)
#define NGW (G * NWAVES)
#define GTID ((size_t)bx * (NWAVES * 64) + tid)
#define GTHREADS ((size_t)G * (NWAVES * 64))
    {
        LAS unsigned* Tl = (LAS unsigned*)lds;
        unsigned char* wsb = (unsigned char*)PTR(22);
        { const float* pW = PTR(I_W_OUT); unsigned* cm = (unsigned*)((unsigned char*)PTR(22) + WS_CMAX_WOUT);
          for (int it = bx; it < (D / 256) * (D / 256); it += G) colmax_item(pW, D, 256 * (it / (D / 256)), 256 * (it % (D / 256)), cm, (LAS f32x4*)(lds + 65536), tid); }
        { const float* pW = PTR(I_W_PQ); const float* kg = PTR(I_NORM_FG); unsigned* cm = (unsigned*)((unsigned char*)PTR(22) + WS_CMAX_WPQ);
          for (int it = bx; it < (D / 256) * (PQW / 256); it += G) colmax_item(pW, PQW, 256 * (it / (PQW / 256)), 256 * (it % (PQW / 256)), cm, (LAS f32x4*)(lds + 65536), tid, kg); }
        cvt_f32_bf16(PTR(I_SUBK), WSP(WS_SUBK), (size_t)8 * 2 * 128 * 128, GTID, GTHREADS);
        { const float* px = PTR(I_X); const float* pg = PTR(I_NORM_MIX_G); bf16* ph = WSP(WS_H);
          unsigned char* ph8 = (unsigned char*)WSP(WS_H8); float* sah = (float*)((unsigned char*)PTR(22) + WS_SA_H);
          for (int m = GW; m < M; m += NGW) rms_row_4096<true>(px + (size_t)m * D, pg, (bf16*)nullptr, ph8 + (size_t)m * LDH8, lane, sah + m); }
        { const float* px = PTR(I_MEM); const float* pg = PTR(I_NORM_MEMG); bf16* ph = WSP(WS_MEMN);
          for (int m = GW; m < NB * NMEM; m += NGW) rms_row_4096<false>(px + (size_t)m * D, pg, ph + (size_t)m * D, nullptr, lane); }
        { const float* pW = PTR(I_W_IN); unsigned* cm = (unsigned*)(wsb + WS_CMAX_WIN);
          for (int it = bx; it < 16 * 48; it += G) { const int kb = it / 48, nb = it % 48; colmax_item(pW, NPROJ, 256 * kb, 256 * nb, cm, (LAS f32x4*)(lds + 65536), tid); } }
    }
    xcd_barrier(bar);
    {
        LAS unsigned* Tl = (LAS unsigned*)lds; unsigned char* wsb = (unsigned char*)PTR(22); constexpr int NI8 = (D / 128) * (NPROJ / 256);
        transpose_matrix<true>(PTR(I_W_IN), D, NPROJ, wsb + WS_WIN8, D, 1.f, nullptr, Tl, bx, G, NI8, tid, (const unsigned*)(wsb + WS_CMAX_WIN));
    }
    xcd_barrier(bar);

    {
        pg8::Gemm g{WSP(WS_H8), WSP(WS_WIN8), M, NPROJ, D / 2, LDH8 / 2, D / 2}; pg8::StaticOrder S; S.init(M, NPROJ, G, bx);
        pg8::EpiProj E{WSP(WS_PROJ), LDP, PTR(I_MOBA_QG), PTR(I_MOBA_KG), WSP(WS_KMEAN), (LAS float*)(lds + RING_BYTES + 1024), RMS_EPS, 0,
                       (const float*)((unsigned char*)PTR(22) + WS_SA_H), (const unsigned*)((unsigned char*)PTR(22) + WS_CMAX_WIN)};
        pg8::gemm_phase<pg8::EpiProj, pg8::StaticOrder, true, true, false, true>(lds, g, S, E);
    }
    xcd_barrier(bar);

    {
        float gq = fmaxf(fabsf(PTR(I_MOBA_QG)[lane]), fabsf(PTR(I_MOBA_QG)[lane + 64])), gk = fmaxf(fabsf(PTR(I_MOBA_KG)[lane]), fabsf(PTR(I_MOBA_KG)[lane + 64]));
#pragma unroll
        for (int o = 1; o < 64; o <<= 1) { gq = fmaxf(gq, __shfl_xor(gq, o)); gk = fmaxf(gk, __shfl_xor(gk, o)); }
        const float thrB = 2.f * (11.3137085f * 1.01f * gq * gk) + 104.f;
        unsigned* qctr = (unsigned*)PTR(22) + CW_QUEUE;
        if (tid == 0) { MISC[71] = 0u; MISC[72] = xb_xcc_id() & 7u; }
        auto fetch = [&]() -> unsigned {
            unsigned st = MISC[71]; const unsigned myx = MISC[72];
            if (!(st & 1u) && (st >> 8) != 0xffu) {
                for (unsigned k = 0; k < 8u; ++k) { const unsigned q = (myx + k) & 7u; if ((st >> (8 + q)) & 1u) continue;
                    const unsigned p = atomicAdd(qctr + 64 * (1 + q), 1u);
                    if (p < 128u) { MISC[71] = st | 1u; return q * 128u + p; }
                    st |= 1u << (8 + q); } }
            MISC[71] = st & ~1u;
            const unsigned c = atomicAdd(qctr, 1u);
            return c < 1568u ? 1024u + c : 0xFFFFu; };
        unsigned nxt_tk = 0u; if (tid == 0) nxt_tk = fetch();
        for (;;) {
            __syncthreads();
            if (tid == 0) MISC[70] = nxt_tk;
            __syncthreads();
            const unsigned u = (unsigned)__builtin_amdgcn_readfirstlane((int)MISC[70]);
            if (u >= 2592u) break;
            if (tid == 0) nxt_tk = fetch();
            if (u >= 1024u && u < 1568u) {
                const int cv = (int)(u - 1024u);
                int tidc = tid; asm volatile("" : "+v"(tidc));
                LAS unsigned* Tl = (LAS unsigned*)lds; unsigned char* wsb = (unsigned char*)PTR(22);
                int it = 8 * cv;
                if (it < 2048) transpose_matrix<true>(PTR(I_V), NEXP, D, wsb + WS_VT8, LDV8, V_SCL, nullptr, Tl, it, 1, it + 8, tidc);
                else if ((it -= 2048) < 512) transpose_matrix<true>(PTR(I_W_OUT), D, D, wsb + WS_WOUT, D, 1.f, nullptr, Tl, it, 1, it + 8, tidc, (const unsigned*)(wsb + WS_CMAX_WOUT));
                else if ((it -= 512) < 256) transpose_matrix<true>(PTR(I_W_PQ), D, PQW, wsb + WS_WPQ, D, 1.f, PTR(I_NORM_FG), Tl, it, 1, it + 8, tidc, (const unsigned*)(wsb + WS_CMAX_WPQ));
                else if ((it -= 256) < 256) transpose_matrix<false>(PTR(I_W_XKV), D, 2 * XW, wsb + WS_WXKV, LDW, 1.f, nullptr, Tl, it, 1, it + 8, tidc);
                else if ((it -= 256) < 128) transpose_matrix<false>(PTR(I_W_XQ), D, XW, wsb + WS_WXQ, LDW, 1.f, PTR(I_NORM_XG), Tl, it, 1, it + 8, tidc);
                else if ((it -= 128) < 128) transpose_matrix<false>(PTR(I_W_XO), XW, D, wsb + WS_WXO, LDXO, 1.f, nullptr, Tl, it, 1, it + 8, tidc);
                else { it -= 128; const size_t e0 = (size_t)it * 65536;
                    cvt_u_fp6(PTR(I_U) + e0, wsb + WS_U8 + (e0 / D) * LDU8, LDU8, (float*)(wsb + WS_SU) + e0 / D, PTR(I_NORM_FG), 128, tidc); }
                continue;
            }
            int tida = tid; asm volatile("" : "+v"(tida));
            if (u < 1024u) { const int q = (int)(u >> 7), p = (int)(u & 127u), lvl = 15 - (p >> 3), j = p & 7, gq_ = q & 3, i_ = j & 3;
                const int hh = i_ == 0 ? gq_ : (i_ == 1 ? 15 - gq_ : (i_ == 2 ? 7 - gq_ : 8 + gq_)), bb = 2 * (q >> 2) + (j >> 2);
                moba_unit((LAS char*)lds, WSP(WS_PROJ), WSP(WS_KMEAN), WSP(WS_AO), bb, hh, lvl, thrB, tida); }
            else { const unsigned a = u - 1568u; const int bh = (int)(a & 63u), lvl = 15 - (int)((a >> 6) & 15u);
                sb_unit((LAS char*)lds, WSP(WS_PROJ), WSP(WS_AO), bh >> 4, bh & 15, lvl, tida); }
        }
    }
    xcd_barrier(bar);

    { const bf16* pa = WSP(WS_AO); unsigned char* p8 = (unsigned char*)WSP(WS_AO8); float* sa = (float*)((unsigned char*)PTR(22) + WS_SA_AO); const float* g1 = PTR(I_MOBA_OG); const float* g2 = PTR(I_SB_OG);
      int lane2 = lane; asm volatile("" : "+v"(lane2));
      for (int m = GW; m < M; m += NGW) outnorm_row(pa + (size_t)m * LDAO, p8 + (size_t)m * D, sa + m, g1, g2, lane2); }
    xcd_barrier(bar);

    {
        pg8::Gemm g{WSP(WS_AO8), WSP(WS_WOUT), M, D, D / 2, D / 2, D / 2}; pg8::StaticOrder S; S.init(M, D, G, bx);
        pg8::EpiResNorm<false, false, true> E{PTR(I_X), D, WSP(WS_H), LDH, nullptr, 0, (unsigned long long*)((unsigned char*)PTR(22) + WS_ROWSS1), 1.f, (unsigned*)((unsigned char*)PTR(22) + WS_ROWMAX1), nullptr, 0, nullptr, (const float*)((unsigned char*)PTR(22) + WS_SA_AO), (const unsigned*)((unsigned char*)PTR(22) + WS_CMAX_WOUT)};
        pg8::gemm_phase<pg8::EpiResNorm<false, false, true>, pg8::StaticOrder, true, true, false, true>(lds, g, S, E);
    }
    xcd_barrier(bar);

    if (G < 160) { const v4u z = {0u, 0u, 0u, 0u}; GAS v4u* gp = (GAS v4u*)WSP(WS_G8); const size_t n16 = (size_t)M * LDG8 / 16; const size_t gs_ = GTHREADS; for (size_t i = GTID; i < n16; i += gs_) gp[i] = z; }
    {
        pg8::Gemm g{WSP(WS_H), WSP(WS_WXQ), M, XW, D, LDH, LDW}; pg8::StaticOrder S; S.init(M, XW, G, bx);
        pg8::EpiBf16Row E{WSP(WS_XQ), XW, (const unsigned long long*)((unsigned char*)PTR(22) + WS_ROWSS1), 5.9604644775390625e-8f / 4096.f, RMS_EPS};
        pg8::gemm_phase<pg8::EpiBf16Row, pg8::StaticOrder, true, true>(lds, g, S, E);
    }
    if (G >= 160 && bx >= 144) {
        const v4u z = {0u, 0u, 0u, 0u}; GAS v4u* gp = (GAS v4u*)WSP(WS_G8); const size_t n16 = (size_t)M * LDG8 / 16;
        const size_t gs_ = (size_t)(G - 144) * (NWAVES * 64); for (size_t i = (size_t)(bx - 144) * (NWAVES * 64) + tid; i < n16; i += gs_) gp[i] = z;
    }
    {
        const int c = (G >= 160) ? bx - 128 : bx;
        if (c >= 0) {
            pg8::Gemm g{WSP(WS_MEMN), WSP(WS_WXKV), NB * NMEM, 2 * XW, D, D, LDW}; pg8::StaticOrder S; S.init(NB * NMEM, 2 * XW, G, c);
            pg8::EpiBf16<0> E{WSP(WS_KVMEM), 2 * XW, nullptr, 0, 0, 1.f};
            pg8::gemm_phase<pg8::EpiBf16<0>, pg8::StaticOrder, true, true>(lds, g, S, E);
        }
    }
    xcd_barrier(bar);

    for (int u = bx; u < 256; u += G) xattn_unit((LAS char*)lds, WSP(WS_XQ), WSP(WS_KVMEM), PTR(I_XQG), PTR(I_XKG), WSP(WS_XO), u >> 6, (u >> 4) & 3, u & 15, tid);
    xcd_barrier(bar);

    {
        pg8::Gemm g{WSP(WS_XO), WSP(WS_WXO), M, D, XW, LDXO, LDXO}; pg8::StaticOrder S; S.init(M, D, G, bx);
        pg8::EpiResNormF6 E{WSP(WS_H), LDH, WSP(WS_H), LDH, (unsigned char*)WSP(WS_H8), LDH8, (unsigned long long*)((unsigned char*)PTR(22) + WS_ROWSS2),
                            (unsigned char*)WSP(WS_H8I), D, (const unsigned*)((unsigned char*)PTR(22) + WS_ROWMAX1)};
        pg8::gemm_phase<pg8::EpiResNormF6, pg8::StaticOrder, true, true>(lds, g, S, E);
    }
    xcd_barrier(bar);

    {
        pg8::Gemm g{WSP(WS_H8I), WSP(WS_WPQ), M, PQW, D / 2, D / 2, D / 2}; pg8::StaticOrder S; S.init(M, PQW, G, bx);
        pg8::EpiBf16RowI8 E{WSP(WS_PQ), PQW, (const unsigned long long*)((unsigned char*)PTR(22) + WS_ROWSS2), 5.9604644775390625e-8f / 4096.f, RMS_EPS,
                            (const unsigned*)((unsigned char*)PTR(22) + WS_ROWMAX1), (const unsigned*)((unsigned char*)PTR(22) + WS_CMAX_WPQ)};
        pg8::gemm_phase<pg8::EpiBf16RowI8, pg8::StaticOrder, true, true, false, true>(lds, g, S, E);
    }
    xcd_barrier(bar);

    for (int u = bx; u < 512; u += G) peer_route_unit((LAS char*)lds, WSP(WS_PQ), WSP(WS_SUBK), (unsigned char*)WSP(WS_G8), u, tid);
    xcd_barrier(bar);

    {
        pg8::Gemm g{WSP(WS_H8), WSP(WS_U8), M, NEXP, D / 2, LDH8 / 2, LDU8 / 2}; pg8::StaticOrder S; S.init(M, NEXP, G, bx);
        pg8::EpiGate8 E{(unsigned char*)WSP(WS_G8), LDG8, 1.25f / 7.5f, (const unsigned long long*)((unsigned char*)PTR(22) + WS_ROWSS2), 5.9604644775390625e-8f / 4096.f, RMS_EPS,
                        (const unsigned*)((unsigned char*)PTR(22) + WS_ROWMAX1), (const float*)((unsigned char*)PTR(22) + WS_SU)};
        pg8::gemm_phase<pg8::EpiGate8, pg8::StaticOrder, true, true, false, false, true>(lds, g, S, E);
    }
    xcd_barrier(bar);

    {
        pg8::Gemm g{WSP(WS_G8), WSP(WS_VT8), M, D, NEXP / 2, LDG8 / 2, LDV8 / 2}; pg8::StaticOrder S; S.init(M, D, G, bx);
        pg8::EpiF32ResB16 E{WSP(WS_H), LDH, OUTP, D, 1.f / (G_SCL * V_SCL)};
        pg8::gemm_phase<pg8::EpiF32ResB16, pg8::StaticOrder, true, true, true>(lds, g, S, E);
    }
}

extern "C" void kernel_launch(void* const* d_in, const int* in_sizes, int n_in, void* d_out, int out_size, void* d_ws, size_t ws_size, hipStream_t stream) {
    static int grid = 0;
    if (grid == 0) {
        if (n_in != 21 || in_sizes[0] != M * D || out_size != M * D || ws_size < WS_END) { fprintf(stderr, "kernel_launch: unexpected shapes (n_in %d, in0 %d, out %d, ws %zu); nothing launched\n", n_in, n_in > 0 ? in_sizes[0] : -1, out_size, ws_size); grid = -1; return; }
        int dev = 0, cus = 0;
        if (hipGetDevice(&dev) != hipSuccess || hipDeviceGetAttribute(&cus, hipDeviceAttributeMultiprocessorCount, dev) != hipSuccess) { grid = -1; return; }
        if (hipFuncSetAttribute((const void*)mk_fwd, hipFuncAttributeMaxDynamicSharedMemorySize, LDS_BYTES) != hipSuccess) { fprintf(stderr, "kernel_launch: hipFuncSetAttribute failed\n"); grid = -1; return; }
        int per_cu = 0;
        if (hipOccupancyMaxActiveBlocksPerMultiprocessor(&per_cu, (const void*)mk_fwd, NWAVES * 64, LDS_BYTES) != hipSuccess || per_cu < 1) fprintf(stderr, "kernel_launch: occupancy query reports %d\n", per_cu);
        (void)hipGetLastError();
        grid = cus;
    }
    if (grid < 0) return;
    if (hipMemsetAsync((char*)d_ws + WS_CTL, 0, CTL_ZERO_BYTES, stream) != hipSuccess) return;
    Args a{};
    for (int i = 0; i < 21; ++i) a.in[i] = (const float*)d_in[i];
    a.out = (float*)d_out; a.ws = (unsigned char*)d_ws;
    hipLaunchKernelGGL(mk_fwd, dim3(grid), dim3(NWAVES * 64), LDS_BYTES, stream, a);
}
```

```cpp
#include <hip/hip_runtime.h>
#include <cstdio>
#include <cstdint>
namespace pg8 {
#define PG8_LAS __attribute__((address_space(3)))
typedef unsigned short bf16_t;
typedef short bf16x8 __attribute__((ext_vector_type(8)));
typedef float f32x4 __attribute__((ext_vector_type(4)));
typedef unsigned u32x4 __attribute__((ext_vector_type(4)));
constexpr int BM = 256, BK = 64, HALF = 128, HTB = HALF * BK * 2  , STAGE_BYTES = 8 * HTB, NXCD = 8, WGM = 4;

__host__ __device__ __forceinline__ int lds_byte(int r, int c) { const int st = (r >> 4) * 2 + (c >> 5), rr = r & 15, cc = c & 31, ob = rr * 64 + cc * 2; return st * 1024 + (ob ^ (((ob >> 9) & 1) << 5)); }
__host__ __device__ __forceinline__ void stage_rc(int b, int& R, int& C) { const int st = b / 1024, sb = b % 1024, swz = sb ^ (((sb >> 9) & 1) << 5); R = (st >> 1) * 16 + swz / 64; C = (st & 1) * 32 + (swz % 64) / 2; }
__host__ __device__ __forceinline__ int perm32(int rho) { const int n = rho >> 4, i = rho & 15; return 8 * (i >> 2) + 4 * n + (i & 3); }

struct Unit { int pm, pn; };
struct Gemm { const bf16_t* A; const bf16_t* Bt; int M, N, K, lda, ldb; };

struct StaticOrder {
    int nM, nN, nwg, G, c;
    __host__ __device__ void init(int M, int N, int G_, int c_) { nM = M / BM; nN = N / BM; nwg = nM * nN; G = G_; c = c_; }
    __host__ __device__ bool next(int i, Unit& u) const {
        const long L = (long)i * G + c; if (L >= nwg) return false;
        int wgid = (int)L; { const int q = nwg / NXCD, r = nwg % NXCD, xcd = wgid % NXCD, off = wgid / NXCD; wgid = (xcd < r ? xcd * (q + 1) : r * (q + 1) + (xcd - r) * q) + off; }
        const int nig = WGM * nN, gid = wgid / nig, fm = gid * WGM, gsz = (nM - fm) < WGM ? (nM - fm) : WGM;
        u.pm = fm + ((wgid % nig) % gsz); u.pn = (wgid % nig) / gsz; return true;
    }
    __device__ __forceinline__ void a_ready(const Unit&) const {}
    __device__ __forceinline__ void done(const Unit&) const {}
};

__device__ __forceinline__ unsigned cvt_pk_bf16(float lo, float hi) { unsigned r; asm volatile("v_cvt_pk_bf16_f32 %0, %1, %2" : "=v"(r) : "v"(lo), "v"(hi)); return r; }
typedef float f32x2 __attribute__((ext_vector_type(2)));
__device__ __forceinline__ f32x2 gelu_pk(f32x2 v) {
    const f32x2 av = __builtin_elementwise_abs(v), d = av * 0.2316418882f + 1.0f;
    f32x2 t; t.x = __builtin_amdgcn_rcpf(d.x); t.y = __builtin_amdgcn_rcpf(d.y);
    f32x2 q = t * 0.5307027145f + (-0.7265760135f); q = q * t + 0.7107068705f; q = q * t + (-0.142248368f); q = q * t + 0.127414796f; q = q * t;
    const f32x2 s = (v * v) * (-0.72134752044f);
    f32x2 e; e.x = __builtin_amdgcn_exp2f(s.x); e.y = __builtin_amdgcn_exp2f(s.y);
    const f32x2 m = v * (q * e), r = v - m;
    f32x2 o; o.x = v.x < 0.f ? m.x : r.x; o.y = v.y < 0.f ? m.y : r.y; return o;
}

template <int ACT  > struct EpiBf16 {
    static constexpr bool PERM = true, AFTER_DRAIN = false; static_assert(ACT == 0 || ACT == 1, "EpiBf16: ACT is 0 (none) or 1 (gelu_pk)");
    bf16_t* O; int ldc; const float* bias; int split_cols; size_t split_stride; float scale0;
    __device__ __forceinline__ void operator()(const f32x4 (&acc)[2][2][4][2], const Unit& u, int wr, int wc, int fr, int fq) const {
        const int row0 = u.pm * BM + wr * 64 + fr; int colt = u.pn * BM; bf16_t* base = O;
        float sc = 1.f; if (split_cols) { const int t = colt / split_cols; base += (size_t)t * split_stride; colt -= t * split_cols; if (t == 0) sc = scale0; }
        const int col0 = colt + wc * 32 + 8 * fq, bcol0 = u.pn * BM + wc * 32 + 8 * fq;
        f32x4 bv[2][2];
#pragma unroll
        for (int bj = 0; bj < 2; ++bj)
#pragma unroll
            for (int n = 0; n < 2; ++n) bv[bj][n] = bias ? *(const f32x4*)(bias + bcol0 + bj * HALF + 4 * n) : (f32x4){0.f, 0.f, 0.f, 0.f};
#pragma unroll
        for (int ai = 0; ai < 2; ++ai)
#pragma unroll
            for (int m = 0; m < 4; ++m) { bf16_t* rowp = base + (size_t)(row0 + ai * HALF + m * 16) * ldc + col0;
#pragma unroll
                for (int bj = 0; bj < 2; ++bj) { f32x4 v0 = acc[ai][bj][m][0] + bv[bj][0], v1 = acc[ai][bj][m][1] + bv[bj][1];
                    if (ACT == 1) { f32x2 a = gelu_pk((f32x2){v0[0], v0[1]}), b = gelu_pk((f32x2){v0[2], v0[3]}), c = gelu_pk((f32x2){v1[0], v1[1]}), d = gelu_pk((f32x2){v1[2], v1[3]});
                        v0 = (f32x4){a.x, a.y, b.x, b.y}; v1 = (f32x4){c.x, c.y, d.x, d.y}; }
                    v0 = v0 * sc; v1 = v1 * sc; u32x4 w; w.x = cvt_pk_bf16(v0[0], v0[1]); w.y = cvt_pk_bf16(v0[2], v0[3]); w.z = cvt_pk_bf16(v1[0], v1[1]); w.w = cvt_pk_bf16(v1[2], v1[3]);
                    *(u32x4*)(rowp + bj * HALF) = w; } }
    }
};

typedef int v8i_t __attribute__((ext_vector_type(8)));
typedef int v4i_t __attribute__((ext_vector_type(4)));
typedef int v2i_t __attribute__((ext_vector_type(2)));
typedef int v6i_t __attribute__((ext_vector_type(6)));
__device__ __forceinline__ v6i_t cat6(v4i_t a, v2i_t b) { v6i_t r; r[0] = a[0]; r[1] = a[1]; r[2] = a[2]; r[3] = a[3]; r[4] = b[0]; r[5] = b[1]; return r; }
__device__ __forceinline__ v8i_t cat8(bf16x8 a, bf16x8 b) { const v4i_t x = __builtin_bit_cast(v4i_t, a), y = __builtin_bit_cast(v4i_t, b); return __builtin_shufflevector(x, y, 0, 1, 2, 3, 4, 5, 6, 7); }
template <class Epi, class Sched, bool ALIGN_EPI = false, bool SP2 = false, bool F8 = false, bool I8 = false, bool F6 = false>
__device__ __forceinline__ void gemm_phase(PG8_LAS unsigned char* lds, const Gemm g, const Sched& S, const Epi& E) {
    int tid_ = threadIdx.x; asm volatile("" : "+v"(tid_));
    const int tid = tid_, wid = __builtin_amdgcn_readfirstlane(tid >> 6), lane = tid & 63, wr = wid >> 2, wc = wid & 3, fr = lane & 15, fq = lane >> 4;
    const int K = g.K, nt = K / BK;
    unsigned voffA[2], voffB[2];
#pragma unroll
    for (int i = 0; i < 2; ++i) { int R, C; stage_rc(tid * 16 + i * 8192, R, C); const int Rb = Epi::PERM ? ((R & ~31) + perm32(R & 31)) : R;
        voffA[i] = (unsigned)(R * g.lda + C) * 2u; voffB[i] = (unsigned)(Rb * g.ldb + C) * 2u; }
    const size_t kstep = (size_t)(BK * 2);
    const size_t hstepA = (size_t)HALF * g.lda * 2, hstepB = (size_t)HALF * g.ldb * 2;
    const size_t tstepA = 2 * hstepA, tstepB = 2 * hstepB;
    const unsigned ldsw = (unsigned)wid * 1024u;
    const int aoff = lds_byte(wr * 64 + fr, fq * 8), boff = lds_byte(wc * 32 + fr, fq * 8);
    const unsigned aaddr = (unsigned)(size_t)lds + (unsigned)aoff, baddr = (unsigned)(size_t)lds + (unsigned)boff + 4u * HTB;
#define PG8_SA(b, h) (((b) * 2 + (h)) * HTB)
#define PG8_SB(b, h) ((4 + (b) * 2 + (h)) * HTB)
#define PG8_STAGE(bufoff, gbase, voff) do { _Pragma("unroll") for (int _i = 0; _i < 2; ++_i) \
        __builtin_amdgcn_global_load_lds((const unsigned*)((const char*)(gbase) + (voff)[_i]), (PG8_LAS unsigned*)(lds + (bufoff) + ldsw + _i * 8192), 16, 0, 0); } while (0)
#define PG8_RD16(d, base, off) asm volatile("ds_read_b128 %0, %1 offset:%2" : "=v"(d) : "v"(base), "i"(off))
#define PG8_RD8(d, base, off) asm volatile("ds_read_b64 %0, %1 offset:%2" : "=v"(d) : "v"(base), "i"(off))
#define PG8_LD6(dst, base, off) do { v4i_t lo_; v2i_t hi_; PG8_RD16(lo_, base, off); PG8_RD8(hi_, base, (off) + 1024); dst = cat6(lo_, hi_); } while (0)
#define PG8_LDA(dst, b, h) do { if constexpr (F6) { PG8_LD6(dst##6[0], aaddr, PG8_SA(b, h)); PG8_LD6(dst##6[1], aaddr, PG8_SA(b, h) + 2048); PG8_LD6(dst##6[2], aaddr, PG8_SA(b, h) + 4096); PG8_LD6(dst##6[3], aaddr, PG8_SA(b, h) + 6144); } else { \
        _Pragma("unroll") for (int m = 0; m < 4; ++m) { if constexpr (F8) { dst##8[m].lo = *(const PG8_LAS v4i_t*)(lds + PG8_SA(b, h) + aoff + m * 2048); dst##8[m].hi = *(const PG8_LAS v4i_t*)(lds + PG8_SA(b, h) + aoff + m * 2048 + 1024); } \
        else { _Pragma("unroll") for (int k = 0; k < 2; ++k) dst[m][k] = *(const PG8_LAS bf16x8*)(lds + PG8_SA(b, h) + aoff + m * 2048 + k * 1024); } } } } while (0)
#define PG8_LDB(dst, b, h) do { if constexpr (F6) { PG8_LD6(dst##6[0], baddr, PG8_SB(b, h) - 4 * HTB); PG8_LD6(dst##6[1], baddr, PG8_SB(b, h) - 4 * HTB + 2048); } else { \
        _Pragma("unroll") for (int n = 0; n < 2; ++n) { if constexpr (F8) { dst##8[n].lo = *(const PG8_LAS v4i_t*)(lds + PG8_SB(b, h) + boff + n * 2048); dst##8[n].hi = *(const PG8_LAS v4i_t*)(lds + PG8_SB(b, h) + boff + n * 2048 + 1024); } \
        else { _Pragma("unroll") for (int k = 0; k < 2; ++k) dst[n][k] = *(const PG8_LAS bf16x8*)(lds + PG8_SB(b, h) + boff + n * 2048 + k * 1024); } } } } while (0)
#define PG8_MMA(ai, bj, At, Bt) do { __builtin_amdgcn_s_setprio(1); \
        if constexpr (F6) { _Pragma("unroll") for (int m = 0; m < 4; ++m) _Pragma("unroll") for (int n = 0; n < 2; ++n) \
            asm volatile("v_mfma_scale_f32_16x16x128_f8f6f4 %0, %1, %2, %0, %3, %3 op_sel_hi:[0,0,0] cbsz:2 blgp:2" : "+v"(acc[ai][bj][m][n]) : "v"(Bt##6[n]), "v"(At##6[m]), "v"(unit_scale)); } \
        else if constexpr (F8) { _Pragma("unroll") for (int m = 0; m < 4; ++m) _Pragma("unroll") for (int n = 0; n < 2; ++n) \
            asm volatile("v_mfma_scale_f32_16x16x128_f8f6f4 %0, %1, %2, %0, %3, %3 op_sel_hi:[0,0,0]" : "+v"(acc[ai][bj][m][n]) : "v"(Bt##8[n]), "v"(At##8[m]), "v"(unit_scale)); } \
        else if constexpr (I8) { _Pragma("unroll") for (int m = 0; m < 4; ++m) _Pragma("unroll") for (int n = 0; n < 2; ++n) _Pragma("unroll") for (int k = 0; k < 2; ++k) \
            acc[ai][bj][m][n] = __builtin_bit_cast(f32x4, __builtin_amdgcn_mfma_i32_16x16x64_i8(__builtin_bit_cast(v4i_t, Bt[n][k]), __builtin_bit_cast(v4i_t, At[m][k]), __builtin_bit_cast(v4i_t, acc[ai][bj][m][n]), 0, 0, 0)); } \
        else { _Pragma("unroll") for (int m = 0; m < 4; ++m) _Pragma("unroll") for (int n = 0; n < 2; ++n) _Pragma("unroll") for (int k = 0; k < 2; ++k) \
            acc[ai][bj][m][n] = __builtin_amdgcn_mfma_f32_16x16x32_bf16(Bt[n][k], At[m][k], acc[ai][bj][m][n], 0, 0, 0); } \
        __builtin_amdgcn_s_setprio(0); } while (0)
#define PG8_WAIT_V(n) asm volatile("s_waitcnt vmcnt(" #n ")" ::: "memory")
#define PG8_WAIT_L(n) asm volatile("s_waitcnt lgkmcnt(" #n ")" ::: "memory")
#define PG8_BAR __builtin_amdgcn_s_barrier()
#define PG8_SCHED __builtin_amdgcn_sched_barrier(0)
    Unit cur, nxt; int ui = 0;
    if (!S.next(0, cur)) return;
    f32x4 acc[2][2][4][2];
#pragma unroll
    for (int a = 0; a < 2; ++a)
#pragma unroll
        for (int b = 0; b < 2; ++b)
#pragma unroll
            for (int m = 0; m < 4; ++m)
#pragma unroll
                for (int n = 0; n < 2; ++n) acc[a][b][m][n] = (f32x4){0.f, 0.f, 0.f, 0.f};
    bf16x8 At[4][2], B0[2][2], B1[2][2];
    const int unit_scale = 0x7f7f7f7f;
    v6i_t At6[4], B06[2], B16[2];
    v8i_t At8[4], B08[2], B18[2];
    const char* cA = (const char*)g.A + (size_t)cur.pm * tstepA; const char* cB = (const char*)g.Bt + (size_t)cur.pn * tstepB;
    S.a_ready(cur);
    if constexpr (SP2) {
        PG8_STAGE(PG8_SB(0, 0), cB, voffB); PG8_STAGE(PG8_SB(0, 1), cB + hstepB, voffB); PG8_STAGE(PG8_SA(0, 0), cA, voffA); PG8_STAGE(PG8_SA(0, 1), cA + hstepA, voffA);
        if (wr == 1) PG8_BAR;
        PG8_WAIT_V(2); PG8_BAR;
        PG8_STAGE(PG8_SB(1, 0), cB + kstep, voffB); PG8_STAGE(PG8_SA(1, 0), cA + kstep, voffA); PG8_STAGE(PG8_SB(1, 1), cB + hstepB + kstep, voffB);
        PG8_WAIT_V(6); PG8_BAR;
    } else {
        PG8_STAGE(PG8_SB(0, 0), cB, voffB); PG8_STAGE(PG8_SA(0, 0), cA, voffA); PG8_STAGE(PG8_SB(0, 1), cB + hstepB, voffB); PG8_STAGE(PG8_SA(0, 1), cA + hstepA, voffA);
        if (wr == 1) PG8_BAR;
        PG8_WAIT_V(4); PG8_BAR;
        PG8_STAGE(PG8_SB(1, 0), cB + kstep, voffB); PG8_STAGE(PG8_SA(1, 0), cA + kstep, voffA); PG8_STAGE(PG8_SB(1, 1), cB + hstepB + kstep, voffB);
        PG8_WAIT_V(6); PG8_BAR;
    }
    for (;;) {
        const bool has_next = S.next(ui + 1, nxt);
        const char* nA = has_next ? (const char*)g.A + (size_t)nxt.pm * tstepA : cA; const char* nB = has_next ? (const char*)g.Bt + (size_t)nxt.pn * tstepB : cB;
        for (int t = 0; t < nt; t += 2) {
            const bool last = (t == nt - 2);
            const char* a1 = cA + (size_t)(t + 1) * kstep;
            const char* a2 = last ? nA : cA + (size_t)(t + 2) * kstep; const char* b2 = last ? nB : cB + (size_t)(t + 2) * kstep;
            const char* a3 = a2 + kstep; const char* b3 = b2 + kstep;
            if (last && has_next) S.a_ready(nxt);
            if constexpr (SP2) {
            PG8_LDB(B0, 0, 0); PG8_LDB(B1, 0, 1); PG8_SCHED; PG8_LDA(At, 0, 0); PG8_STAGE(PG8_SA(1, 1), a1 + hstepA, voffA);
            PG8_WAIT_V(8); PG8_WAIT_L(0); PG8_BAR; PG8_MMA(0, 0, At, B0); PG8_MMA(0, 1, At, B1); PG8_BAR; PG8_SCHED;
            PG8_LDA(At, 0, 1); PG8_STAGE(PG8_SB(0, 0), b2, voffB); PG8_STAGE(PG8_SB(0, 1), b2 + hstepB, voffB); PG8_STAGE(PG8_SA(0, 0), a2, voffA);
            PG8_WAIT_V(8); PG8_WAIT_L(0); PG8_BAR; PG8_MMA(1, 0, At, B0); PG8_MMA(1, 1, At, B1); PG8_BAR; PG8_SCHED;
            PG8_LDB(B0, 1, 0); PG8_LDB(B1, 1, 1); PG8_SCHED; PG8_LDA(At, 1, 0); PG8_STAGE(PG8_SA(0, 1), a2 + hstepA, voffA);
            PG8_WAIT_V(8); PG8_WAIT_L(0); PG8_BAR; PG8_MMA(0, 0, At, B0); PG8_MMA(0, 1, At, B1); PG8_BAR; PG8_SCHED;
            PG8_LDA(At, 1, 1); PG8_STAGE(PG8_SB(1, 0), b3, voffB); PG8_STAGE(PG8_SB(1, 1), b3 + hstepB, voffB); PG8_STAGE(PG8_SA(1, 0), a3, voffA);
            PG8_WAIT_V(8); PG8_WAIT_L(0); PG8_BAR; PG8_MMA(1, 0, At, B0); PG8_MMA(1, 1, At, B1); PG8_BAR; PG8_SCHED;
            } else {
            PG8_LDB(B0, 0, 0); PG8_SCHED; PG8_LDA(At, 0, 0); PG8_STAGE(PG8_SA(1, 1), a1 + hstepA, voffA);
            PG8_WAIT_L(8); PG8_BAR; PG8_WAIT_L(0); PG8_MMA(0, 0, At, B0); PG8_BAR; PG8_SCHED;
            PG8_LDB(B1, 0, 1); PG8_STAGE(PG8_SB(0, 0), b2, voffB);
            PG8_BAR; PG8_WAIT_L(0); PG8_MMA(0, 1, At, B1); PG8_BAR;
            PG8_LDA(At, 0, 1); PG8_STAGE(PG8_SA(0, 0), a2, voffA);
            PG8_BAR; PG8_WAIT_L(0); PG8_MMA(1, 0, At, B0); PG8_BAR; PG8_SCHED;
            PG8_STAGE(PG8_SB(0, 1), b2 + hstepB, voffB);
            PG8_WAIT_V(6); PG8_BAR; PG8_MMA(1, 1, At, B1); PG8_BAR;
            PG8_LDB(B0, 1, 0); PG8_SCHED; PG8_LDA(At, 1, 0); PG8_STAGE(PG8_SA(0, 1), a2 + hstepA, voffA);
            PG8_WAIT_L(8); PG8_BAR; PG8_WAIT_L(0); PG8_MMA(0, 0, At, B0); PG8_BAR; PG8_SCHED;
            PG8_LDB(B1, 1, 1); PG8_STAGE(PG8_SB(1, 0), b3, voffB);
            PG8_BAR; PG8_WAIT_L(0); PG8_MMA(0, 1, At, B1); PG8_BAR;
            PG8_LDA(At, 1, 1); PG8_STAGE(PG8_SA(1, 0), a3, voffA);
            PG8_BAR; PG8_WAIT_L(0); PG8_MMA(1, 0, At, B0); PG8_BAR; PG8_SCHED;
            PG8_STAGE(PG8_SB(1, 1), b3 + hstepB, voffB);
            PG8_WAIT_V(6); PG8_BAR; PG8_MMA(1, 1, At, B1); PG8_BAR;
            }
        }
        if constexpr (F8 || F6) asm volatile("s_nop 15\n\ts_nop 15" ::: "memory");
        if constexpr (ALIGN_EPI) { if (wr == 0) PG8_BAR; }
        if constexpr (!Epi::AFTER_DRAIN) { E(acc, cur, wr, wc, fr, fq); S.done(cur); }
        if (!has_next) break;
#pragma unroll
        for (int a = 0; a < 2; ++a)
#pragma unroll
            for (int b = 0; b < 2; ++b)
#pragma unroll
                for (int m = 0; m < 4; ++m)
#pragma unroll
                    for (int n = 0; n < 2; ++n) acc[a][b][m][n] = (f32x4){0.f, 0.f, 0.f, 0.f};
        cur = nxt; cA = nA; cB = nB; ++ui;
        if constexpr (ALIGN_EPI) { if (wr == 1) PG8_BAR; }
    }
    PG8_WAIT_V(0);
    if constexpr (!ALIGN_EPI) { if (wr == 0) PG8_BAR; }
    PG8_BAR;
    if constexpr (Epi::AFTER_DRAIN) { E.fused(acc, cur, wr, wc, fr, fq, lds, wid, lane); S.done(cur); }
#undef PG8_SA
#undef PG8_SB
#undef PG8_STAGE
#undef PG8_LDA
#undef PG8_RD16
#undef PG8_RD8
#undef PG8_LD6
#undef PG8_LDB
#undef PG8_MMA
#undef PG8_WAIT_V
#undef PG8_WAIT_L
#undef PG8_BAR
#undef PG8_SCHED
}
}

namespace pg8 {
template <int CTRL> __device__ __forceinline__ float dpp_f(float x) { return __builtin_bit_cast(float, __builtin_amdgcn_mov_dpp(__builtin_bit_cast(int, x), CTRL, 0xf, 0xf, true)); }
__device__ __forceinline__ float row16_sum(float x) { x += dpp_f<0xB1>(x); x += dpp_f<0x4E>(x); x += dpp_f<0x141>(x); x += dpp_f<0x128>(x); return x; }
__device__ __forceinline__ float fq4_sum(float x) {
    const auto s = __builtin_amdgcn_permlane16_swap(__float_as_uint(x), __float_as_uint(x), false, false); x = __uint_as_float(s[0]) + __uint_as_float(s[1]);
    const auto t = __builtin_amdgcn_permlane32_swap(__float_as_uint(x), __float_as_uint(x), false, false); return __uint_as_float(t[0]) + __uint_as_float(t[1]); }
__device__ __forceinline__ float fq4_max(float x) {
    const auto s = __builtin_amdgcn_permlane16_swap(__float_as_uint(x), __float_as_uint(x), false, false); x = fmaxf(__uint_as_float(s[0]), __uint_as_float(s[1]));
    const auto t = __builtin_amdgcn_permlane32_swap(__float_as_uint(x), __float_as_uint(x), false, false); return fmaxf(__uint_as_float(t[0]), __uint_as_float(t[1])); }
struct EpiF32Res {
    static constexpr bool PERM = false, AFTER_DRAIN = false;
    const float* base; float* out; int ldc; float scl;
    __device__ __forceinline__ void operator()(const f32x4 (&acc)[2][2][4][2], const Unit& u, int wr, int wc, int fr, int fq) const {
        const int row0 = u.pm * BM + wr * 64 + fr, col0 = u.pn * BM + wc * 32 + 4 * fq;
#pragma unroll
        for (int ai = 0; ai < 2; ++ai) {
            f32x4 bs[4][2][2];
#pragma unroll
            for (int m = 0; m < 4; ++m) { const size_t off = (size_t)(row0 + ai * HALF + m * 16) * ldc + col0;
#pragma unroll
                for (int bj = 0; bj < 2; ++bj)
#pragma unroll
                    for (int n = 0; n < 2; ++n) bs[m][bj][n] = *(const f32x4*)(base + off + bj * HALF + n * 16); }
#pragma unroll
            for (int m = 0; m < 4; ++m) { const size_t off = (size_t)(row0 + ai * HALF + m * 16) * ldc + col0;
#pragma unroll
                for (int bj = 0; bj < 2; ++bj)
#pragma unroll
                    for (int n = 0; n < 2; ++n) *(f32x4*)(out + off + bj * HALF + n * 16) = bs[m][bj][n] + acc[ai][bj][m][n] * scl; }
        }
    }
};
struct EpiGate {
    static constexpr bool PERM = true, AFTER_DRAIN = false;
    bf16_t* G; int ldc;
    __device__ __forceinline__ void operator()(const f32x4 (&acc)[2][2][4][2], const Unit& u, int wr, int wc, int fr, int fq) const {
        const int row0 = u.pm * BM + wr * 64 + fr, col0 = u.pn * BM + wc * 32 + 8 * fq;
#pragma unroll
        for (int ai = 0; ai < 2; ++ai)
#pragma unroll
            for (int m = 0; m < 4; ++m) { bf16_t* rowp = G + (size_t)(row0 + ai * HALF + m * 16) * ldc + col0;
#pragma unroll
                for (int bj = 0; bj < 2; ++bj) { const u32x4 g = *(const u32x4*)(rowp + bj * HALF);
                    if ((g.x | g.y | g.z | g.w) != 0u) {
                        const f32x4 v0 = acc[ai][bj][m][0], v1 = acc[ai][bj][m][1];
                        const f32x2 a = gelu_pk((f32x2){v0[0], v0[1]}), b = gelu_pk((f32x2){v0[2], v0[3]}), c = gelu_pk((f32x2){v1[0], v1[1]}), d = gelu_pk((f32x2){v1[2], v1[3]});
                        u32x4 w;
                        w.x = cvt_pk_bf16(a.x * __uint_as_float(g.x << 16), a.y * __uint_as_float(g.x & 0xffff0000u));
                        w.y = cvt_pk_bf16(b.x * __uint_as_float(g.y << 16), b.y * __uint_as_float(g.y & 0xffff0000u));
                        w.z = cvt_pk_bf16(c.x * __uint_as_float(g.z << 16), c.y * __uint_as_float(g.z & 0xffff0000u));
                        w.w = cvt_pk_bf16(d.x * __uint_as_float(g.w << 16), d.y * __uint_as_float(g.w & 0xffff0000u));
                        *(u32x4*)(rowp + bj * HALF) = w; } } }
    }
};
template <bool BASE16, bool WITH_F8, bool ACC_I8 = false, bool WITH_I8 = false> struct EpiResNorm {
    static constexpr bool PERM = false, AFTER_DRAIN = false;
    const void* base; int ldbase; bf16_t* X16; int ld16; unsigned char* X8; int ld8; unsigned long long* rowss; float scl;
    unsigned* rowmax;
    unsigned char* X8i; int ld8i; const unsigned* qmax;
    const float* sa; const unsigned* sbmax;
    __device__ __forceinline__ void operator()(const f32x4 (&acc)[2][2][4][2], const Unit& u, int wr, int wc, int fr, int fq) const {
        typedef unsigned u32x2 __attribute__((ext_vector_type(2)));
        const int row0 = u.pm * BM + wr * 64 + fr, col0 = u.pn * BM + wc * 32 + 4 * fq;
#pragma unroll
        for (int ai = 0; ai < 2; ++ai) {
            f32x4 bs[4][2][2];
#pragma unroll
            for (int m = 0; m < 4; ++m) { const size_t off = (size_t)(row0 + ai * HALF + m * 16) * ldbase + col0;
#pragma unroll
                for (int bj = 0; bj < 2; ++bj)
#pragma unroll
                    for (int n = 0; n < 2; ++n) {
                        if constexpr (BASE16) { const u32x2 w = *(const u32x2*)((const bf16_t*)base + off + bj * HALF + n * 16);
                            bs[m][bj][n] = (f32x4){__uint_as_float(w.x << 16), __uint_as_float(w.x & 0xffff0000u), __uint_as_float(w.y << 16), __uint_as_float(w.y & 0xffff0000u)}; }
                        else bs[m][bj][n] = *(const f32x4*)((const float*)base + off + bj * HALF + n * 16); } }
#pragma unroll
            for (int m = 0; m < 4; ++m) { const int row = row0 + ai * HALF + m * 16; const size_t off = (size_t)row * ld16 + col0, off8 = (size_t)row * ld8 + col0; float ss = 0.f, mx = 0.f;
                float qinv = 0.f; if constexpr (WITH_I8) { const float qm = __uint_as_float(qmax[row]); qinv = qm > 0.f ? 127.f / (1.25f * qm) : 0.f; }
#pragma unroll
                for (int bj = 0; bj < 2; ++bj)
#pragma unroll
                    for (int n = 0; n < 2; ++n) { f32x4 a_ = acc[ai][bj][m][n];
                        if constexpr (ACC_I8) { const v4i_t ai_ = __builtin_bit_cast(v4i_t, a_); const u32x4 sm = *(const u32x4*)(sbmax + (col0 + bj * HALF + n * 16));
                            const float sr = sa[row] * (1.f / 127.f);
                            a_ = (f32x4){(float)ai_[0] * (sr * __uint_as_float(sm.x)), (float)ai_[1] * (sr * __uint_as_float(sm.y)), (float)ai_[2] * (sr * __uint_as_float(sm.z)), (float)ai_[3] * (sr * __uint_as_float(sm.w))}; }
                        const f32x4 v = bs[m][bj][n] + a_ * scl;
                        ss += (v[0] * v[0] + v[1] * v[1]) + (v[2] * v[2] + v[3] * v[3]);
                        mx = fmaxf(fmaxf(mx, fmaxf(fabsf(v[0]), fabsf(v[1]))), fmaxf(fabsf(v[2]), fabsf(v[3])));
                        if constexpr (WITH_I8) { unsigned q = 0u; q = __builtin_amdgcn_cvt_pk_u8_f32(rintf(v[0] * qinv) + 128.f, 0, q); q = __builtin_amdgcn_cvt_pk_u8_f32(rintf(v[1] * qinv) + 128.f, 1, q); q = __builtin_amdgcn_cvt_pk_u8_f32(rintf(v[2] * qinv) + 128.f, 2, q); q = __builtin_amdgcn_cvt_pk_u8_f32(rintf(v[3] * qinv) + 128.f, 3, q);
                            *(unsigned*)(X8i + (size_t)row * ld8i + col0 + bj * HALF + n * 16) = q ^ 0x80808080u; }
                        u32x2 w; w.x = cvt_pk_bf16(v[0], v[1]); w.y = cvt_pk_bf16(v[2], v[3]); *(u32x2*)(X16 + off + bj * HALF + n * 16) = w;
                        if constexpr (WITH_F8) { int t = 0; t = __builtin_amdgcn_cvt_pk_fp8_f32(v[0], v[1], t, false); t = __builtin_amdgcn_cvt_pk_fp8_f32(v[2], v[3], t, true); *(unsigned*)(X8 + off8 + bj * HALF + n * 16) = (unsigned)t; } }
                ss = fq4_sum(ss);
                if (rowmax) { mx = fq4_max(mx); }
                if (fq == 0) { atomicAdd(rowss + row, (unsigned long long)(ss * 16777216.f + 0.5f)); if (rowmax) atomicMax(rowmax + row, __float_as_uint(mx)); } }
        }
    }
};
struct EpiResNormF6 {
    static constexpr bool PERM = false, AFTER_DRAIN = false;
    const bf16_t* base; int ldbase; bf16_t* X16; int ld16; unsigned char* X6; int ld6; unsigned long long* rowss; unsigned char* X8i; int ld8i; const unsigned* qmax;
    __device__ __forceinline__ void operator()(const f32x4 (&acc)[2][2][4][2], const Unit& u, int wr, int wc, int fr, int fq) const {
        typedef unsigned u32x2 __attribute__((ext_vector_type(2)));
        typedef float v16f_t __attribute__((ext_vector_type(16)));
        typedef unsigned v6u_t __attribute__((ext_vector_type(6)));
        const int row0 = u.pm * BM + wr * 64 + fr, col0 = u.pn * BM + wc * 32 + 4 * fq;
        const int g6off = (u.pn * 2 + (wc >> 1)) * 128 + ((wc & 1) * 2 + (fq >> 1)) * 16;
#pragma unroll
        for (int ai = 0; ai < 2; ++ai)
#pragma unroll
            for (int mp = 0; mp < 2; ++mp) {
                u32x2 bs[2][2][2];
#pragma unroll
                for (int mm = 0; mm < 2; ++mm) { const size_t off = (size_t)(row0 + ai * HALF + (2 * mp + mm) * 16) * ldbase + col0;
#pragma unroll
                    for (int bj = 0; bj < 2; ++bj)
#pragma unroll
                        for (int n = 0; n < 2; ++n) bs[mm][bj][n] = *(const u32x2*)(base + off + bj * HALF + n * 16); }
                v16f_t V[2];
#pragma unroll
                for (int mm = 0; mm < 2; ++mm) { const int m = 2 * mp + mm, row = row0 + ai * HALF + m * 16; const size_t off = (size_t)row * ld16 + col0; float ss = 0.f;
                    const float qm = __uint_as_float(qmax[row]); const float qinv = qm > 0.f ? 127.f / (1.25f * qm) : 0.f, finv = qm > 0.f ? 7.5f / (1.25f * qm) : 0.f;
#pragma unroll
                    for (int bj = 0; bj < 2; ++bj)
#pragma unroll
                        for (int n = 0; n < 2; ++n) { const u32x2 w0 = bs[mm][bj][n];
                            const f32x4 v = (f32x4){__uint_as_float(w0.x << 16), __uint_as_float(w0.x & 0xffff0000u), __uint_as_float(w0.y << 16), __uint_as_float(w0.y & 0xffff0000u)} + acc[ai][bj][m][n];
                            ss += (v[0] * v[0] + v[1] * v[1]) + (v[2] * v[2] + v[3] * v[3]);
                            { unsigned q = 0u; q = __builtin_amdgcn_cvt_pk_u8_f32(rintf(v[0] * qinv) + 128.f, 0, q); q = __builtin_amdgcn_cvt_pk_u8_f32(rintf(v[1] * qinv) + 128.f, 1, q); q = __builtin_amdgcn_cvt_pk_u8_f32(rintf(v[2] * qinv) + 128.f, 2, q); q = __builtin_amdgcn_cvt_pk_u8_f32(rintf(v[3] * qinv) + 128.f, 3, q);
                              *(unsigned*)(X8i + (size_t)row * ld8i + col0 + bj * HALF + n * 16) = q ^ 0x80808080u; }
                            u32x2 w; w.x = cvt_pk_bf16(v[0], v[1]); w.y = cvt_pk_bf16(v[2], v[3]); *(u32x2*)(X16 + off + bj * HALF + n * 16) = w;
#pragma unroll
                            for (int j = 0; j < 4; ++j) V[mm][(bj * 2 + n) * 4 + j] = __builtin_amdgcn_fmed3f(v[j] * finv, -7.5f, 7.5f); }
                    ss = fq4_sum(ss);
                    if (fq == 0) atomicAdd(rowss + row, (unsigned long long)(ss * 16777216.f + 0.5f)); }
#pragma unroll
                for (int i = 0; i < 16; ++i) { const auto r = __builtin_amdgcn_permlane16_swap(__float_as_uint(V[0][i]), __float_as_uint(V[1][i]), false, false); V[0][i] = __uint_as_float(r[0]); V[1][i] = __uint_as_float(r[1]); }
                const v6u_t o = __builtin_amdgcn_cvt_scalef32_2xpk16_fp6_f32(V[0], V[1], 1.0f);
                unsigned char* dp = X6 + (size_t)(row0 + ai * HALF + (2 * mp + (fq & 1)) * 16) * ld6 + g6off;
                *(u32x4*)dp = (u32x4){o[0], o[1], o[2], o[3]}; *(u32x2*)(dp + 64) = (u32x2){o[4], o[5]};
            }
    }
};
struct EpiF32ResB16 {
    static constexpr bool PERM = false, AFTER_DRAIN = false;
    const bf16_t* base; int ldbase; float* out; int ldc; float scl;
    __device__ __forceinline__ void operator()(const f32x4 (&acc)[2][2][4][2], const Unit& u, int wr, int wc, int fr, int fq) const {
        typedef unsigned u32x2 __attribute__((ext_vector_type(2)));
        const int row0 = u.pm * BM + wr * 64 + fr, col0 = u.pn * BM + wc * 32 + 4 * fq;
        u32x2 bs[2][4][2][2];
#pragma unroll
        for (int ai = 0; ai < 2; ++ai)
#pragma unroll
            for (int m = 0; m < 4; ++m) { const size_t off = (size_t)(row0 + ai * HALF + m * 16) * ldbase + col0;
#pragma unroll
                for (int bj = 0; bj < 2; ++bj)
#pragma unroll
                    for (int n = 0; n < 2; ++n) bs[ai][m][bj][n] = *(const u32x2*)(base + off + bj * HALF + n * 16); }
#pragma unroll
        for (int ai = 0; ai < 2; ++ai)
#pragma unroll
            for (int m = 0; m < 4; ++m) { const size_t off = (size_t)(row0 + ai * HALF + m * 16) * ldc + col0;
#pragma unroll
                for (int bj = 0; bj < 2; ++bj)
#pragma unroll
                    for (int n = 0; n < 2; ++n) { const u32x2 w = bs[ai][m][bj][n];
                        const f32x4 b = {__uint_as_float(w.x << 16), __uint_as_float(w.x & 0xffff0000u), __uint_as_float(w.y << 16), __uint_as_float(w.y & 0xffff0000u)};
                        *(f32x4*)(out + off + bj * HALF + n * 16) = b + acc[ai][bj][m][n] * scl; } }
    }
};
struct EpiBf16Row {
    static constexpr bool PERM = true, AFTER_DRAIN = false;
    bf16_t* O; int ldc; const unsigned long long* rowss; float inv_n, eps;
    __device__ __forceinline__ void operator()(const f32x4 (&acc)[2][2][4][2], const Unit& u, int wr, int wc, int fr, int fq) const {
        const int row0 = u.pm * BM + wr * 64 + fr, col0 = u.pn * BM + wc * 32 + 8 * fq;
#pragma unroll
        for (int ai = 0; ai < 2; ++ai)
#pragma unroll
            for (int m = 0; m < 4; ++m) { const int row = row0 + ai * HALF + m * 16; bf16_t* rowp = O + (size_t)row * ldc + col0;
                const float r = 1.0f / sqrtf((float)rowss[row] * inv_n + eps);
#pragma unroll
                for (int bj = 0; bj < 2; ++bj) { const f32x4 v0 = acc[ai][bj][m][0] * r, v1 = acc[ai][bj][m][1] * r;
                    u32x4 w; w.x = cvt_pk_bf16(v0[0], v0[1]); w.y = cvt_pk_bf16(v0[2], v0[3]); w.z = cvt_pk_bf16(v1[0], v1[1]); w.w = cvt_pk_bf16(v1[2], v1[3]);
                    *(u32x4*)(rowp + bj * HALF) = w; } }
    }
};
struct EpiBf16RowI8 {
    static constexpr bool PERM = true, AFTER_DRAIN = false;
    bf16_t* O; int ldc; const unsigned long long* rowss; float inv_n, eps; const unsigned* qmax; const unsigned* cmax;
    __device__ __forceinline__ void operator()(const f32x4 (&acc)[2][2][4][2], const Unit& u, int wr, int wc, int fr, int fq) const {
        const int row0 = u.pm * BM + wr * 64 + fr, col0 = u.pn * BM + wc * 32 + 8 * fq;
        f32x4 sb[2][2];
#pragma unroll
        for (int bj = 0; bj < 2; ++bj)
#pragma unroll
            for (int n = 0; n < 2; ++n) { const u32x4 cm = *(const u32x4*)(cmax + col0 + bj * HALF + 4 * n); sb[bj][n] = (f32x4){__uint_as_float(cm.x), __uint_as_float(cm.y), __uint_as_float(cm.z), __uint_as_float(cm.w)} * (1.f / 127.f); }
#pragma unroll
        for (int ai = 0; ai < 2; ++ai)
#pragma unroll
            for (int m = 0; m < 4; ++m) { const int row = row0 + ai * HALF + m * 16; bf16_t* rowp = O + (size_t)row * ldc + col0;
                const float r = (1.25f / 127.f) * __uint_as_float(qmax[row]) / sqrtf((float)rowss[row] * inv_n + eps);
#pragma unroll
                for (int bj = 0; bj < 2; ++bj) { const v4i_t i0 = __builtin_bit_cast(v4i_t, acc[ai][bj][m][0]), i1 = __builtin_bit_cast(v4i_t, acc[ai][bj][m][1]);
                    const f32x4 v0 = (f32x4){(float)i0[0], (float)i0[1], (float)i0[2], (float)i0[3]} * sb[bj][0] * r, v1 = (f32x4){(float)i1[0], (float)i1[1], (float)i1[2], (float)i1[3]} * sb[bj][1] * r;
                    u32x4 w; w.x = cvt_pk_bf16(v0[0], v0[1]); w.y = cvt_pk_bf16(v0[2], v0[3]); w.z = cvt_pk_bf16(v1[0], v1[1]); w.w = cvt_pk_bf16(v1[2], v1[3]);
                    *(u32x4*)(rowp + bj * HALF) = w; } }
    }
};
struct EpiProj {
    static constexpr bool PERM = true, AFTER_DRAIN = false;
    bf16_t* O; int ldc; const float* gq; const float* gk; bf16_t* KMEAN; PG8_LAS float* X; float eps; int pn_skip;
    const float* sa; const unsigned* cmax;
    __device__ __forceinline__ void operator()(const f32x4 (&acc)[2][2][4][2], const Unit& u, int wr, int wc, int fr_, int fq_) const {
        int fr = fr_, fq = fq_; asm volatile("" : "+v"(fr), "+v"(fq));
        const int pcol = u.pn < 16 ? u.pn : u.pn + pn_skip;
        const int row0 = u.pm * BM + wr * 64 + fr;
        bf16_t* const hb0 = O + ((size_t)(((pcol >> 3) * 64 + (u.pm >> 4) * 16 + (pcol & 7) * 2) * 4096 + (u.pm & 15) * 256 + wr * 64 + fr)) * 128 + wc * 32 + 8 * fq;
        constexpr size_t HSTEP = (size_t)4096 * 128;
        if (sa) {
            f32x4 (&A)[2][2][4][2] = const_cast<f32x4 (&)[2][2][4][2]>(acc);
            const int n0 = u.pn * BM + wc * 32 + 8 * fq;
#pragma unroll
            for (int bj = 0; bj < 2; ++bj)
#pragma unroll
                for (int n = 0; n < 2; ++n) { const u32x4 cm = *(const u32x4*)(cmax + n0 + bj * HALF + 4 * n);
                    const f32x4 sb = (f32x4){__uint_as_float(cm.x), __uint_as_float(cm.y), __uint_as_float(cm.z), __uint_as_float(cm.w)} * (1.f / 127.f);
#pragma unroll
                    for (int ai = 0; ai < 2; ++ai)
#pragma unroll
                        for (int m = 0; m < 4; ++m) { const v4i_t iv = __builtin_bit_cast(v4i_t, A[ai][bj][m][n]); const float sr = sa[row0 + ai * HALF + m * 16];
                            A[ai][bj][m][n] = (f32x4){(float)iv[0], (float)iv[1], (float)iv[2], (float)iv[3]} * sb * sr; } }
        }
        if (u.pn >= 16) {
#pragma unroll
            for (int ai = 0; ai < 2; ++ai)
#pragma unroll
                for (int m = 0; m < 4; ++m) { bf16_t* rowp = hb0 + (size_t)(ai * HALF + m * 16) * 128;
#pragma unroll
                    for (int bj = 0; bj < 2; ++bj) { const f32x4 v0 = acc[ai][bj][m][0], v1 = acc[ai][bj][m][1];
                        u32x4 w; w.x = cvt_pk_bf16(v0[0], v0[1]); w.y = cvt_pk_bf16(v0[2], v0[3]); w.z = cvt_pk_bf16(v1[0], v1[1]); w.w = cvt_pk_bf16(v1[2], v1[3]);
                        *(u32x4*)(rowp + bj * HSTEP) = w; } }
            return;
        }
        const bool isk = u.pn >= 8;
#pragma unroll
        for (int ai = 0; ai < 2; ++ai)
#pragma unroll
            for (int m = 0; m < 4; ++m)
#pragma unroll
                for (int bj = 0; bj < 2; ++bj) { const f32x4 a = acc[ai][bj][m][0], b = acc[ai][bj][m][1];
                    float ss = ((a[0] * a[0] + a[1] * a[1]) + (a[2] * a[2] + a[3] * a[3])) + ((b[0] * b[0] + b[1] * b[1]) + (b[2] * b[2] + b[3] * b[3]));
                    ss = fq4_sum(ss);
                    if (fq == 0) X[((ai * HALF + wr * 64 + m * 16 + fr) * 2 + bj) * 4 + wc] = ss; __builtin_amdgcn_sched_barrier(0); }
        asm volatile("s_waitcnt lgkmcnt(0)" ::: "memory"); __builtin_amdgcn_s_barrier(); asm volatile("" ::: "memory");
        const float* g = isk ? gk : gq;
        const f32x4 ga = *(const f32x4*)(g + wc * 32 + 8 * fq), gb = *(const f32x4*)(g + wc * 32 + 8 * fq + 4);
        f32x4 cs[2][2];
#pragma unroll
        for (int bj = 0; bj < 2; ++bj) { cs[bj][0] = (f32x4){0.f, 0.f, 0.f, 0.f}; cs[bj][1] = (f32x4){0.f, 0.f, 0.f, 0.f}; }
#pragma unroll
        for (int ai = 0; ai < 2; ++ai)
#pragma unroll
            for (int m = 0; m < 4; ++m) { const int rowl = ai * HALF + wr * 64 + m * 16 + fr; bf16_t* rowp = hb0 + (size_t)(ai * HALF + m * 16) * 128;
#pragma unroll
                for (int bj = 0; bj < 2; ++bj) { const f32x4 p = *(const PG8_LAS f32x4*)(X + (rowl * 2 + bj) * 4);
                    const float r = 1.0f / sqrtf(((p[0] + p[1]) + (p[2] + p[3])) * (1.f / 128.f) + eps);
                    const f32x4 v0 = acc[ai][bj][m][0] * r * ga, v1 = acc[ai][bj][m][1] * r * gb;
                    cs[bj][0] += v0; cs[bj][1] += v1; asm volatile("" : "+v"(cs[bj][0]), "+v"(cs[bj][1]));
                    u32x4 w; w.x = cvt_pk_bf16(v0[0], v0[1]); w.y = cvt_pk_bf16(v0[2], v0[3]); w.z = cvt_pk_bf16(v1[0], v1[1]); w.w = cvt_pk_bf16(v1[2], v1[3]);
                    *(u32x4*)(rowp + bj * HSTEP) = w; __builtin_amdgcn_sched_barrier(0); } }
        if (isk) {
            PG8_LAS float* C = X + 2048;
#pragma unroll
            for (int bj = 0; bj < 2; ++bj)
#pragma unroll
                for (int n = 0; n < 2; ++n)
#pragma unroll
                    for (int j = 0; j < 4; ++j) { float s = cs[bj][n][j];
                        s = row16_sum(s);
                        if (fr == 0) C[(wr * 2 + bj) * 128 + wc * 32 + 8 * fq + 4 * n + j] = s; __builtin_amdgcn_sched_barrier(0); }
            asm volatile("s_waitcnt lgkmcnt(0)" ::: "memory"); __builtin_amdgcn_s_barrier(); asm volatile("" ::: "memory");
            const int t = (wr * 4 + wc) * 64 + fq * 16 + fr;
            if (t < 256) { const int bj = t >> 7, ch = t & 127; const float s = C[(0 * 2 + bj) * 128 + ch] + C[(1 * 2 + bj) * 128 + ch];
                const int hh = (u.pn - 8) * 2 + bj, bb = u.pm >> 4, blk = u.pm & 15;
                const unsigned q = __float_as_uint(s * (1.f / 256.f)); KMEAN[((size_t)((bb * 16 + hh) * 16 + blk)) * 128 + ch] = (bf16_t)((q + 0x7fffu + ((q >> 16) & 1u)) >> 16); }
        }
    }
};
struct EpiBf16MapI8 {
    static constexpr bool PERM = true, AFTER_DRAIN = false;
    bf16_t* O; int ldc; int pn0, pn1; const float* sa; const unsigned* cmax;
    __device__ __forceinline__ void operator()(const f32x4 (&acc)[2][2][4][2], const Unit& u, int wr, int wc, int fr, int fq) const {
        const int pcol = u.pn < 8 ? pn0 + u.pn : pn1 + u.pn - 8;
        const int row0 = u.pm * BM + wr * 64 + fr, col0 = pcol * BM + wc * 32 + 8 * fq, n0 = u.pn * BM + wc * 32 + 8 * fq;
        f32x4 sb[2][2];
#pragma unroll
        for (int bj = 0; bj < 2; ++bj)
#pragma unroll
            for (int n = 0; n < 2; ++n) { const u32x4 cm = *(const u32x4*)(cmax + n0 + bj * HALF + 4 * n); sb[bj][n] = (f32x4){__uint_as_float(cm.x), __uint_as_float(cm.y), __uint_as_float(cm.z), __uint_as_float(cm.w)} * (1.f / 127.f); }
#pragma unroll
        for (int ai = 0; ai < 2; ++ai)
#pragma unroll
            for (int m = 0; m < 4; ++m) { const int row = row0 + ai * HALF + m * 16; bf16_t* rowp = O + (size_t)row * ldc + col0; const float sr = sa[row];
#pragma unroll
                for (int bj = 0; bj < 2; ++bj) { const v4i_t i0 = __builtin_bit_cast(v4i_t, acc[ai][bj][m][0]), i1 = __builtin_bit_cast(v4i_t, acc[ai][bj][m][1]);
                    const f32x4 v0 = (f32x4){(float)i0[0], (float)i0[1], (float)i0[2], (float)i0[3]} * sb[bj][0] * sr, v1 = (f32x4){(float)i1[0], (float)i1[1], (float)i1[2], (float)i1[3]} * sb[bj][1] * sr;
                    u32x4 w; w.x = cvt_pk_bf16(v0[0], v0[1]); w.y = cvt_pk_bf16(v0[2], v0[3]); w.z = cvt_pk_bf16(v1[0], v1[1]); w.w = cvt_pk_bf16(v1[2], v1[3]);
                    *(u32x4*)(rowp + bj * HALF) = w; } }
    }
};
struct EpiGate8 {
    static constexpr bool PERM = true, AFTER_DRAIN = false;
    unsigned char* G; int ldc; float ascl; const unsigned long long* rowss; float inv_n, eps;
    const unsigned* qmax; const float* su;
    __device__ __forceinline__ void operator()(const f32x4 (&acc)[2][2][4][2], const Unit& u, int wr, int wc, int fr, int fq) const {
        typedef unsigned u32x2 __attribute__((ext_vector_type(2)));
        const int row0 = u.pm * BM + wr * 64 + fr, col0 = u.pn * BM + wc * 32 + 8 * fq;
        u32x2 gg[2][4][2];
#pragma unroll
        for (int ai = 0; ai < 2; ++ai)
#pragma unroll
            for (int m = 0; m < 4; ++m)
#pragma unroll
                for (int bj = 0; bj < 2; ++bj) gg[ai][m][bj] = *(const u32x2*)(G + (size_t)(row0 + ai * HALF + m * 16) * ldc + col0 + bj * HALF);
        f32x4 sv[2][2];
#pragma unroll
        for (int bj = 0; bj < 2; ++bj) { sv[bj][0] = *(const f32x4*)(su + col0 + bj * HALF); sv[bj][1] = *(const f32x4*)(su + col0 + bj * HALF + 4); }
#pragma unroll
        for (int ai = 0; ai < 2; ++ai)
#pragma unroll
            for (int m = 0; m < 4; ++m) { const int row = row0 + ai * HALF + m * 16; unsigned char* rowp = G + (size_t)row * ldc + col0;
                const float rs = ascl * __uint_as_float(qmax[row]) / sqrtf((float)rowss[row] * inv_n + eps);
#pragma unroll
                for (int bj = 0; bj < 2; ++bj) { const u32x2 g = gg[ai][m][bj]; const f32x4 s0 = sv[bj][0], s1 = sv[bj][1];
                    unsigned long long gq = ((unsigned long long)g.y << 32) | (unsigned long long)g.x, outq = 0ull;
                    const f32x4 v0 = acc[ai][bj][m][0], v1 = acc[ai][bj][m][1];
                    while (__any(gq != 0ull)) {
                        if (gq != 0ull) {
                            const int p = __builtin_ctzll(gq) >> 3;
                            const float gv = __builtin_amdgcn_cvt_f32_fp8((int)(unsigned)(gq >> (8 * p)), 0);
                            const float a01 = (p & 1) ? v0[1] : v0[0], a23 = (p & 1) ? v0[3] : v0[2], a45 = (p & 1) ? v1[1] : v1[0], a67 = (p & 1) ? v1[3] : v1[2];
                            const float a03 = (p & 2) ? a23 : a01, a47 = (p & 2) ? a67 : a45;
                            const float s01 = (p & 1) ? s0[1] : s0[0], s23 = (p & 1) ? s0[3] : s0[2], s45 = (p & 1) ? s1[1] : s1[0], s67 = (p & 1) ? s1[3] : s1[2];
                            const float s03 = (p & 2) ? s23 : s01, s47 = (p & 2) ? s67 : s45;
                            const float x = ((p & 4) ? a47 : a03) * (((p & 4) ? s47 : s03) * rs);
                            const f32x2 ge = gelu_pk((f32x2){x, 0.f});
                            const unsigned byte = (unsigned)__builtin_amdgcn_cvt_pk_fp8_f32(ge.x * gv, 0.f, 0, false) & 0xffu;
                            outq |= (unsigned long long)byte << (8 * p);
                            gq &= ~(0xffull << (8 * p));
                        }
                    }
                    if ((g.x | g.y) != 0u) { u32x2 w; w.x = (unsigned)outq; w.y = (unsigned)(outq >> 32); *(u32x2*)(rowp + bj * HALF) = w; } } }
    }
};
}

constexpr int NB = 4, T = 4096, D = 4096, M = NB * T;
constexpr int NPROJ = 12288;
constexpr int NMEM = 256, XW = 512, PQW = 2048, NEXP = 16384;
constexpr float RMS_EPS = 1e-6f;
constexpr int NWAVES = 8;

constexpr size_t MiB = 1u << 20;
constexpr size_t WS_CTL = 0, CTL_ZERO_BYTES = 1 * MiB;
constexpr int LDH = D, LDW = D, LDAO = D, LDP = NPROJ, LDXO = XW, LDH8 = D, LDU8 = D, LDG8 = NEXP, LDV8 = NEXP;
constexpr size_t WS_KMEAN = 1 * MiB;
constexpr size_t WS_SUBK = 2 * MiB;
constexpr size_t WS_MEMN = 4 * MiB;
constexpr size_t WS_KVMEM = 12 * MiB;
constexpr size_t WS_WXQ = 16 * MiB;
constexpr size_t WS_WXKV = 21 * MiB;
constexpr size_t WS_WXO = 30 * MiB;
constexpr size_t WS_WPQ = 35 * MiB;
constexpr size_t WS_WOUT = 53 * MiB;
constexpr size_t WS_WIN8 = 88 * MiB;
constexpr size_t WS_PQ = 88 * MiB;
constexpr size_t WS_AO8 = 88 * MiB;
constexpr size_t WS_XQ = 152 * MiB;
constexpr size_t WS_XO = 168 * MiB;
constexpr size_t WS_U8 = 191 * MiB;
constexpr size_t WS_VT8 = 257 * MiB;
constexpr size_t WS_H = 322 * MiB;
constexpr size_t WS_H8 = 452 * MiB;
constexpr size_t WS_PROJ = 518 * MiB;
constexpr size_t WS_AO = 904 * MiB;
constexpr size_t WS_G8 = 518 * MiB;
constexpr size_t WS_END = 1034 * MiB;
static_assert(WS_WXQ + (size_t)XW * LDW * 2 <= WS_WXKV && WS_WXKV + (size_t)2 * XW * LDW * 2 <= WS_WXO && WS_WXO + (size_t)D * LDXO * 2 <= WS_WPQ && WS_WPQ + (size_t)PQW * LDW * 2 <= WS_WOUT && WS_WOUT + (size_t)D * LDW * 2 <= WS_WIN8, "ws map 1");
static_assert(WS_WIN8 + (size_t)NPROJ * D <= WS_U8 && WS_XO + (size_t)M * LDXO * 2 <= WS_U8 && WS_U8 + (size_t)NEXP * LDU8 <= WS_VT8 && WS_VT8 + (size_t)D * LDV8 <= WS_H && WS_H + (size_t)M * LDH * 2 <= WS_H8, "ws map 2");
static_assert(WS_H8 + (size_t)M * LDH8 <= WS_PROJ && WS_PROJ + (size_t)M * LDP * 2 <= WS_AO && WS_AO + (size_t)M * LDAO * 2 <= WS_END && WS_G8 + (size_t)M * LDG8 <= WS_AO, "ws map 3");
constexpr float U_SCL = 64.f, V_SCL = 4.f, G_SCL = 16.f, WO_SCL = 64.f;
constexpr int CW_BAR = 4096;
constexpr size_t WS_CMAX_WIN = 524288 + 65536;
constexpr size_t WS_SA_H = 1 * MiB + 512 * 1024 + 65536;
constexpr size_t WS_ROWMAX1 = 655360;
constexpr size_t WS_SU = 786432;
constexpr size_t WS_CMAX_WPQ = 720896;
constexpr size_t WS_H8I = 776 * MiB;
constexpr size_t WS_CMAX_WOUT = 524288;
constexpr size_t WS_SA_AO = 1 * MiB + 512 * 1024;
constexpr int CW_QUEUE = 8192;
constexpr size_t WS_ROWSS1 = 65536, WS_ROWSS2 = 262144;

constexpr int RING_BYTES = 131072;
constexpr int MISC_OFF = RING_BYTES + 320;
constexpr int LDS_BYTES = 147456;

#define GAS __attribute__((address_space(1)))
#define LAS __attribute__((address_space(3)))
typedef unsigned short bf16;
typedef unsigned v4u __attribute__((ext_vector_type(4)));
typedef float f32x4 __attribute__((ext_vector_type(4)));
typedef short bf16x8 __attribute__((ext_vector_type(8)));
typedef GAS unsigned gu32;
typedef GAS unsigned long long gu64;
#define RLX_AGENT __ATOMIC_RELAXED, __HIP_MEMORY_SCOPE_AGENT
#define LDS_WAIT() asm volatile("s_waitcnt lgkmcnt(0)" ::: "memory")
#define VM_WAIT() asm volatile("s_waitcnt vmcnt(0)" ::: "memory")
__device__ __forceinline__ unsigned long long rt() { return __builtin_amdgcn_s_memrealtime(); }
__device__ __forceinline__ unsigned f2bf(float f) { unsigned u = __builtin_bit_cast(unsigned, f); return (u + 0x7fffu + ((u >> 16) & 1u)) >> 16; }
__device__ __forceinline__ unsigned pk2(float lo, float hi) { return f2bf(lo) | (f2bf(hi) << 16); }

#define XB_TMO      128
#define XB_XCNT(j)  (256  + 64 * (j))
#define XB_XSUB(j)  (1280 + 64 * (j))
#define XB_XGEN(j)  (2304 + 64 * (j))
#define XB_TOP      3328
#define XB_TOPGEN   3392
#define XCD_BAR_WORDS 3456
#define XB_SPIN_CAP (1u << 18)

__device__ __forceinline__ unsigned xb_ld(unsigned* p)              { return __hip_atomic_load(p, __ATOMIC_RELAXED, __HIP_MEMORY_SCOPE_AGENT); }
__device__ __forceinline__ unsigned xb_add(unsigned* p, unsigned v) { return __hip_atomic_fetch_add(p, v, __ATOMIC_RELAXED, __HIP_MEMORY_SCOPE_AGENT); }
__device__ __forceinline__ unsigned xb_xcc_id() { return (unsigned)__builtin_amdgcn_s_getreg((3 << 11) | 20) & 0xFu; }
#define XB_SPIN(cond, bar) do { unsigned _sp = 0; while (cond) { __builtin_amdgcn_s_sleep(1); \
    if ((++_sp & 255u) == 0u) { if (xb_ld(&(bar)[XB_TMO])) break; if (_sp > XB_SPIN_CAP) { atomicAdd(&(bar)[XB_TMO], 1u); break; } } } } while (0)

struct XcdBarrier {
    unsigned* bar; unsigned x;
    volatile LAS unsigned* st;
};

__device__ __forceinline__ XcdBarrier xcd_barrier_post(unsigned* bar, volatile LAS unsigned* st) {
    XcdBarrier b; b.bar = bar; b.x = xb_xcc_id(); b.st = st;
    if (threadIdx.x == 0) (void)xb_add(&bar[XB_XCNT(b.x)], 1u);
    return b;
}
__device__ __forceinline__ void xcd_barrier_complete(unsigned* bar, unsigned x, unsigned& nloc, unsigned& nx) {
    const unsigned G = gridDim.x * gridDim.y * gridDim.z;
    unsigned sum, cnt, mine, sp = 0u;
    for (;;) {
        sum = 0u; cnt = 0u; mine = 0u;
#pragma unroll
        for (unsigned j = 0; j < 16; ++j) { const unsigned c = xb_ld(&bar[XB_XCNT(j)]); sum += c; cnt += (c > 0u) ? 1u : 0u; mine = (j == x) ? c : mine; }
        if (sum == G) break;
        __builtin_amdgcn_s_sleep(1);
        if ((++sp & 255u) == 0u) { if (xb_ld(&bar[XB_TMO])) break; if (sp > XB_SPIN_CAP) { atomicAdd(&bar[XB_TMO], 1u); break; } }
    }
    nloc = mine > 0u ? mine : 1u; nx = cnt > 0u ? cnt : 1u;
}

__device__ __forceinline__ void xcd_barrier(const XcdBarrier& b) {
    asm volatile("s_waitcnt vmcnt(0)" ::: "memory");
    __syncthreads();
    if (threadIdx.x == 0) {
        unsigned* bar = b.bar;
        __builtin_amdgcn_s_waitcnt(0);
        unsigned nloc = b.st[0], nx = b.st[1];
        if (nloc == 0u) { xcd_barrier_complete(bar, b.x, nloc, nx); b.st[0] = nloc; b.st[1] = nx; }
        const unsigned old = xb_add(&bar[XB_XSUB(b.x)], 1u);
        const unsigned gen = old / nloc;
        if (old + 1u == (gen + 1u) * nloc) {
            __builtin_amdgcn_fence(__ATOMIC_RELEASE, "agent");
            asm volatile("s_waitcnt vmcnt(0)" ::: "memory");
            const unsigned og = xb_add(&bar[XB_TOP], 1u);
            const unsigned tg = og / nx;
            if (og + 1u == (tg + 1u) * nx) xb_add(&bar[XB_TOPGEN], 1u);
            else XB_SPIN(xb_ld(&bar[XB_TOPGEN]) == tg, bar);
            __builtin_amdgcn_fence(__ATOMIC_ACQUIRE, "agent");
            xb_add(&bar[XB_XGEN(b.x)], 1u);
            asm volatile("s_waitcnt vmcnt(0)" ::: "memory");
        } else {
            XB_SPIN(xb_ld(&bar[XB_XGEN(b.x)]) == gen, bar);
            __builtin_amdgcn_fence(__ATOMIC_ACQUIRE, "agent");
            asm volatile("s_waitcnt vmcnt(0)" ::: "memory");
        }
    }
    __syncthreads();
}
typedef unsigned v2u __attribute__((ext_vector_type(2)));
typedef float f32x16 __attribute__((ext_vector_type(16)));
typedef short s16x4 __attribute__((ext_vector_type(4)));
typedef short v2s __attribute__((ext_vector_type(2)));
#define SBAR() __builtin_amdgcn_sched_barrier(0)

__device__ __forceinline__ float bflo(unsigned w) { return __uint_as_float(w << 16); }
__device__ __forceinline__ float bfhi(unsigned w) { return __uint_as_float(w & 0xffff0000u); }
__device__ __forceinline__ float wave_sum(float v) {
#pragma unroll
    for (int o = 1; o < 64; o <<= 1) v += __shfl_xor(v, o);
    return v;
}
__device__ __forceinline__ void pair_get(unsigned x, unsigned& v0, unsigned& v1) { auto rr = __builtin_amdgcn_permlane32_swap(x, x, false, false); v0 = rr[0]; v1 = rr[1]; }
__device__ __forceinline__ float pair_max(float x) { unsigned a, b; pair_get(__float_as_uint(x), a, b); return fmaxf(__uint_as_float(a), __uint_as_float(b)); }
__device__ __forceinline__ float pair_sum(float x) { unsigned a, b; pair_get(__float_as_uint(x), a, b); return __uint_as_float(a) + __uint_as_float(b); }
__device__ __forceinline__ int pair_sumi(int x) { unsigned a, b; pair_get((unsigned)x, a, b); return (int)(a + b); }
__device__ __forceinline__ float pair_other(float x, int hi) { unsigned a, b; pair_get(__float_as_uint(x), a, b); return __uint_as_float(hi ? a : b); }


__device__ __forceinline__ unsigned pk4_fp8(float a, float b, float c, float e) { int t = 0; t = __builtin_amdgcn_cvt_pk_fp8_f32(a, b, t, false); t = __builtin_amdgcn_cvt_pk_fp8_f32(c, e, t, true); return (unsigned)t; }
__device__ __forceinline__ unsigned pk4_i8(float a, float b, float c, float e) { unsigned w = 0u;
    w = __builtin_amdgcn_cvt_pk_u8_f32(rintf(a) + 128.f, 0, w); w = __builtin_amdgcn_cvt_pk_u8_f32(rintf(b) + 128.f, 1, w); w = __builtin_amdgcn_cvt_pk_u8_f32(rintf(c) + 128.f, 2, w); w = __builtin_amdgcn_cvt_pk_u8_f32(rintf(e) + 128.f, 3, w);
    return w ^ 0x80808080u; }
__device__ __forceinline__ void colmax_item(const float* W, int N, int k0, int n0, unsigned* cmax, LAS f32x4* scr, int tid, const float* kgain = nullptr) {
    const int q = tid & 63, rp = tid >> 6;
    f32x4 mx = {0.f, 0.f, 0.f, 0.f};
#pragma unroll 8
    for (int j = 0; j < 32; ++j) { f32x4 v = *(const GAS f32x4*)(W + (size_t)(k0 + rp + 8 * j) * N + n0 + 4 * q); if (kgain) v = v * kgain[k0 + rp + 8 * j];
        mx = (f32x4){fmaxf(mx[0], fabsf(v[0])), fmaxf(mx[1], fabsf(v[1])), fmaxf(mx[2], fabsf(v[2])), fmaxf(mx[3], fabsf(v[3]))}; }
    __syncthreads();
    scr[rp * 64 + q] = mx;
    __syncthreads();
    if (tid < 64) {
#pragma unroll
        for (int w = 1; w < 8; ++w) { const f32x4 o = scr[w * 64 + q]; mx = (f32x4){fmaxf(mx[0], o[0]), fmaxf(mx[1], o[1]), fmaxf(mx[2], o[2]), fmaxf(mx[3], o[3])}; }
#pragma unroll
        for (int i = 0; i < 4; ++i) atomicMax(cmax + n0 + 4 * q + i, __float_as_uint(mx[i])); }
}
template <bool F8> struct TrRegs { f32x4 v[F8 ? 16 : 8]; };
template <bool F8> __device__ __forceinline__ void transpose_load(TrRegs<F8>& R, const float* W, int N, int nblk, int item, int tid) {
    constexpr int KI = F8 ? 128 : 64, RW = F8 ? 16 : 8;
    const int wave = tid >> 6, lane = tid & 63;
    const int kb = item / nblk, nb = item % nblk, k0 = KI * kb, n0 = 256 * nb;
    const float* src = W + (size_t)(k0 + RW * wave) * N + n0 + 4 * lane;
#pragma unroll
    for (int j = 0; j < RW; ++j) R.v[j] = *(const GAS f32x4*)(src + (size_t)j * N);
}
template <bool F8> __device__ __forceinline__ void transpose_flush(TrRegs<F8>& R, const float* W, int K, int N, void* WT, int ldo, float scl, const float* kgain, LAS unsigned* Tl, int item, int next_item, int tid, const unsigned* cmax = nullptr, int nblk = 0) {
    if (nblk == 0) nblk = N / 256;
    constexpr int KI = F8 ? 128 : 64, RW = F8 ? 16 : 8;
    const int wave = tid >> 6, lane = tid & 63;
    const int kb = item / nblk, nb = item % nblk, k0 = KI * kb, n0 = 256 * nb;
    if (kgain) {
#pragma unroll
        for (int j = 0; j < RW; ++j) R.v[j] = R.v[j] * kgain[k0 + RW * wave + j]; }
    float qs[4] = {0.f, 0.f, 0.f, 0.f};
    if (F8 && cmax) { const v4u cm = *(const GAS v4u*)(cmax + n0 + 4 * lane);
        qs[0] = cm.x ? 127.f / __uint_as_float(cm.x) : 0.f; qs[1] = cm.y ? 127.f / __uint_as_float(cm.y) : 0.f; qs[2] = cm.z ? 127.f / __uint_as_float(cm.z) : 0.f; qs[3] = cm.w ? 127.f / __uint_as_float(cm.w) : 0.f; }
    __syncthreads();
#pragma unroll
    for (int jq = 0; jq < 4; ++jq)
#pragma unroll
        for (int i = 0; i < 4; ++i) { unsigned w;
            if constexpr (F8) { if (cmax) { const float s = qs[i]; w = pk4_i8(R.v[4 * jq][i] * s, R.v[4 * jq + 1][i] * s, R.v[4 * jq + 2][i] * s, R.v[4 * jq + 3][i] * s); }
                else w = pk4_fp8(R.v[4 * jq][i] * scl, R.v[4 * jq + 1][i] * scl, R.v[4 * jq + 2][i] * scl, R.v[4 * jq + 3][i] * scl); }
            else w = pk2(R.v[2 * jq][i], R.v[2 * jq + 1][i]);
            Tl[(4 * lane + i) * 32 + ((4 * wave + jq) ^ (4 * (lane & 7)))] = w; }
    __syncthreads();
    if (next_item >= 0) transpose_load<F8>(R, W, N, nblk, next_item, tid);
    const int n = tid >> 1, h = tid & 1;
    unsigned char* dst = (unsigned char*)WT + ((size_t)(n0 + n) * ldo + k0) * (F8 ? 1 : 2) + 64 * h;
#pragma unroll
    for (int q = 0; q < 4; ++q) { const v4u t = *(const LAS v4u*)(Tl + n * 32 + ((16 * h + 4 * q) ^ (4 * ((n >> 2) & 7)))); *(GAS v4u*)(dst + 16 * q) = t; }
}
template <bool F8> __device__ __forceinline__ void transpose_matrix(const float* W, int K, int N, void* WT, int ldo, float scl, const float* kgain, LAS unsigned* Tl, int first, int stride, int NI, int tid, const unsigned* cmax = nullptr, int nblk = 0) {
    if (nblk == 0) nblk = N / 256;
    if (first >= NI) return;
    TrRegs<F8> R; transpose_load<F8>(R, W, N, nblk, first, tid);
    for (int it = first; it < NI; it += stride) { const int nx = it + stride < NI ? it + stride : -1; transpose_flush<F8>(R, W, K, N, WT, ldo, scl, kgain, Tl, it, nx, tid, cmax, nblk); }
}
template <bool WITH_F8> __device__ __forceinline__ void rms_row_4096(const float* xrow, const float* g, bf16* orow, unsigned char* orow8, int lane, float* sa = nullptr) {
    const GAS f32x4* xr = (const GAS f32x4*)xrow + lane;
    f32x4 v[16]; float s = 0.f;
#pragma unroll
    for (int j = 0; j < 16; ++j) { v[j] = xr[64 * j]; s += (v[j].x * v[j].x + v[j].y * v[j].y) + (v[j].z * v[j].z + v[j].w * v[j].w); }
    const float r = 1.0f / sqrtf(wave_sum(s) * (1.f / 4096.f) + RMS_EPS);
    const GAS f32x4* gr = (const GAS f32x4*)g + lane;
    GAS v2u* o8 = (GAS v2u*)orow + lane;
    float amax = 0.f;
#pragma unroll
    for (int j = 0; j < 16; ++j) { const f32x4 gg = gr[64 * j]; v[j] = (f32x4){v[j].x * r * gg.x, v[j].y * r * gg.y, v[j].z * r * gg.z, v[j].w * r * gg.w};
        if (orow) { v2u w; w.x = pk2(v[j].x, v[j].y); w.y = pk2(v[j].z, v[j].w); o8[64 * j] = w; }
        amax = fmaxf(fmaxf(amax, fmaxf(fabsf(v[j].x), fabsf(v[j].y))), fmaxf(fabsf(v[j].z), fabsf(v[j].w))); }
    if constexpr (WITH_F8) {
        if (sa) {
#pragma unroll
            for (int o = 1; o < 64; o <<= 1) amax = fmaxf(amax, __shfl_xor(amax, o));
            const float inv = amax > 0.f ? 127.f / amax : 0.f;
            if (lane == 0) *sa = amax * (1.f / 127.f);
#pragma unroll
            for (int j = 0; j < 16; ++j) ((GAS unsigned*)orow8)[lane + 64 * j] = pk4_i8(v[j].x * inv, v[j].y * inv, v[j].z * inv, v[j].w * inv);
        } else {
#pragma unroll
            for (int j = 0; j < 16; ++j) ((GAS unsigned*)orow8)[lane + 64 * j] = pk4_fp8(v[j].x, v[j].y, v[j].z, v[j].w); }
    }
}
__device__ __forceinline__ void cvt_f32_fp8(const float* src, unsigned char* dst, int ldo, size_t n, float scl, const float* cgain, int ncol, size_t gtid, size_t gthreads) {
    for (size_t i = gtid * 16; i < n; i += gthreads * 16) { f32x4 a = *(const GAS f32x4*)(src + i), b = *(const GAS f32x4*)(src + i + 4), c = *(const GAS f32x4*)(src + i + 8), e = *(const GAS f32x4*)(src + i + 12);
        { const float* gp = cgain + (i % (size_t)ncol); a = a * *(const GAS f32x4*)gp; b = b * *(const GAS f32x4*)(gp + 4); c = c * *(const GAS f32x4*)(gp + 8); e = e * *(const GAS f32x4*)(gp + 12); }
        v4u o; o.x = pk4_fp8(a.x * scl, a.y * scl, a.z * scl, a.w * scl); o.y = pk4_fp8(b.x * scl, b.y * scl, b.z * scl, b.w * scl); o.z = pk4_fp8(c.x * scl, c.y * scl, c.z * scl, c.w * scl); o.w = pk4_fp8(e.x * scl, e.y * scl, e.z * scl, e.w * scl);
        *(GAS v4u*)(dst + (i / (size_t)ncol) * (size_t)ldo + (i % (size_t)ncol)) = o; }
}
__device__ __forceinline__ void cvt_u_fp6(const float* src, unsigned char* dst, int ldo, float* su, const float* cgain, int nrows, int tid) {
    typedef float v16f_t __attribute__((ext_vector_type(16)));
    typedef unsigned v6u_t __attribute__((ext_vector_type(6)));
    typedef unsigned u32x2_t __attribute__((ext_vector_type(2)));
    const int wave = tid >> 6, lane = tid & 63;
    for (int r = wave; r < nrows; r += 8) { const float* rp = src + (size_t)r * 4096;
        v16f_t X[2], Y[2]; float mx = 0.f;
#pragma unroll
        for (int h = 0; h < 2; ++h) { const int g = lane + 64 * h, kt = g >> 2, gq = g & 3, cb = (kt >> 1) * 256 + (((kt & 1) << 1) | (gq >> 1)) * 32 + (gq & 1) * 8;
#pragma unroll
            for (int bj = 0; bj < 2; ++bj)
#pragma unroll
                for (int n = 0; n < 2; ++n) { const int c = cb + bj * 128 + n * 16;
                    const f32x4 a = *(const GAS f32x4*)(rp + c) * *(const GAS f32x4*)(cgain + c), b = *(const GAS f32x4*)(rp + c + 4) * *(const GAS f32x4*)(cgain + c + 4);
#pragma unroll
                    for (int j = 0; j < 4; ++j) { X[h][(bj * 2 + n) * 4 + j] = a[j]; Y[h][(bj * 2 + n) * 4 + j] = b[j]; mx = fmaxf(mx, fmaxf(fabsf(a[j]), fabsf(b[j]))); } } }
        mx = fmaxf(mx, pg8::dpp_f<0xB1>(mx)); mx = fmaxf(mx, pg8::dpp_f<0x4E>(mx)); mx = fmaxf(mx, pg8::dpp_f<0x141>(mx)); mx = fmaxf(mx, pg8::dpp_f<0x128>(mx)); mx = pg8::fq4_max(mx);
        const float s = mx > 0.f ? 7.5f / mx : 0.f;
        if (lane == 0) su[r] = mx * (1.f / 7.5f);
#pragma unroll
        for (int h = 0; h < 2; ++h) { const int g = lane + 64 * h;
#pragma unroll
            for (int i = 0; i < 16; ++i) { X[h][i] = __builtin_amdgcn_fmed3f(X[h][i] * s, -7.5f, 7.5f); Y[h][i] = __builtin_amdgcn_fmed3f(Y[h][i] * s, -7.5f, 7.5f); }
            const v6u_t o = __builtin_amdgcn_cvt_scalef32_2xpk16_fp6_f32(X[h], Y[h], 1.0f);
            unsigned char* dp = dst + (size_t)r * ldo + (g >> 2) * 128 + (g & 3) * 16;
            *(GAS v4u*)dp = (v4u){o[0], o[1], o[2], o[3]}; *(GAS u32x2_t*)(dp + 64) = (u32x2_t){o[4], o[5]}; }
    }
}
__device__ __forceinline__ void cvt_f32_bf16(const float* src, bf16* dst, size_t n, size_t gtid, size_t gthreads) {
    for (size_t i = gtid * 8; i < n; i += gthreads * 8) { const f32x4 a = *(const GAS f32x4*)(src + i), b = *(const GAS f32x4*)(src + i + 4);
        v4u o; o.x = pk2(a.x, a.y); o.y = pk2(a.z, a.w); o.z = pk2(b.x, b.y); o.w = pk2(b.z, b.w); *(GAS v4u*)(dst + i) = o; }
}

__device__ __forceinline__ void qknorm_unit(bf16* PROJ, int row0, int col0, const float* g, bf16* km, LAS float* scr, int tid) {
    const int rr = tid >> 4, ch = tid & 15, wid = tid >> 6, lane = tid & 63;
    float gg[8];
#pragma unroll
    for (int j = 0; j < 8; ++j) gg[j] = g[ch * 8 + j];
    float cs[8] = {0.f, 0.f, 0.f, 0.f, 0.f, 0.f, 0.f, 0.f};
    v4u wv[8];
#pragma unroll
    for (int p = 0; p < 8; ++p) wv[p] = *(const GAS v4u*)(PROJ + (size_t)(row0 + p * 32 + rr) * LDP + col0 + ch * 8);
#pragma unroll
    for (int p = 0; p < 8; ++p) {
        bf16* ptr = PROJ + (size_t)(row0 + p * 32 + rr) * LDP + col0 + ch * 8;
        const v4u w = wv[p];
        float x[8] = {bflo(w.x), bfhi(w.x), bflo(w.y), bfhi(w.y), bflo(w.z), bfhi(w.z), bflo(w.w), bfhi(w.w)};
        float ss = 0.f;
#pragma unroll
        for (int j = 0; j < 8; ++j) ss += x[j] * x[j];
        ss += __shfl_xor(ss, 1); ss += __shfl_xor(ss, 2); ss += __shfl_xor(ss, 4); ss += __shfl_xor(ss, 8);
        const float r = 1.0f / sqrtf(ss * (1.f / 128.f) + RMS_EPS);
#pragma unroll
        for (int j = 0; j < 8; ++j) { x[j] = x[j] * r * gg[j]; cs[j] += x[j]; }
        v4u o; o.x = pk2(x[0], x[1]); o.y = pk2(x[2], x[3]); o.z = pk2(x[4], x[5]); o.w = pk2(x[6], x[7]);
        *(GAS v4u*)ptr = o;
    }
    if (km) {
#pragma unroll
        for (int j = 0; j < 8; ++j) { cs[j] += __shfl_xor(cs[j], 16); cs[j] += __shfl_xor(cs[j], 32); }
        if (lane < 16) {
#pragma unroll
            for (int j = 0; j < 8; ++j) scr[wid * 128 + ch * 8 + j] = cs[j]; }
        __syncthreads();
        if (tid < 128) { float s = 0.f;
#pragma unroll
            for (int w = 0; w < 8; ++w) s += scr[w * 128 + tid];
            km[tid] = (bf16)f2bf(s * (1.f / 256.f)); }
        __syncthreads();
    }
}

__device__ __forceinline__ void outnorm_row(const bf16* row, unsigned char* orow8, float* sa, const float* gm, const float* gs, int lane) {
    v4u w[8]; float s0 = 0.f, s1 = 0.f;
#pragma unroll
    for (int j = 0; j < 8; ++j) { w[j] = *(const GAS v4u*)(row + (size_t)(lane + 64 * j) * 8);
        const float x[8] = {bflo(w[j].x), bfhi(w[j].x), bflo(w[j].y), bfhi(w[j].y), bflo(w[j].z), bfhi(w[j].z), bflo(w[j].w), bfhi(w[j].w)};
        float ss = 0.f;
#pragma unroll
        for (int k = 0; k < 8; ++k) ss += x[k] * x[k];
        if (j < 4) s0 += ss; else s1 += ss; }
    const float r0 = 1.0f / sqrtf(wave_sum(s0) * (1.f / 2048.f) + RMS_EPS), r1 = 1.0f / sqrtf(wave_sum(s1) * (1.f / 2048.f) + RMS_EPS);
    float y[8][8]; float amax = 0.f;
#pragma unroll
    for (int j = 0; j < 8; ++j) { const int c = (lane + 64 * j) * 8; const float* g = (j < 4) ? (gm + c) : (gs + c - 2048); const float r = (j < 4) ? r0 : r1;
        const f32x4 ga = *(const GAS f32x4*)g, gb = *(const GAS f32x4*)(g + 4);
        y[j][0] = bflo(w[j].x) * r * ga.x; y[j][1] = bfhi(w[j].x) * r * ga.y; y[j][2] = bflo(w[j].y) * r * ga.z; y[j][3] = bfhi(w[j].y) * r * ga.w;
        y[j][4] = bflo(w[j].z) * r * gb.x; y[j][5] = bfhi(w[j].z) * r * gb.y; y[j][6] = bflo(w[j].w) * r * gb.z; y[j][7] = bfhi(w[j].w) * r * gb.w;
#pragma unroll
        for (int k = 0; k < 8; ++k) amax = fmaxf(amax, fabsf(y[j][k])); }
#pragma unroll
    for (int o = 1; o < 64; o <<= 1) amax = fmaxf(amax, __shfl_xor(amax, o));
    const float inv = amax > 0.f ? 127.f / amax : 0.f;
    if (lane == 0) *sa = amax * (1.f / 127.f);
#pragma unroll
    for (int j = 0; j < 8; ++j) { v2u o; o.x = pk4_i8(y[j][0] * inv, y[j][1] * inv, y[j][2] * inv, y[j][3] * inv); o.y = pk4_i8(y[j][4] * inv, y[j][5] * inv, y[j][6] * inv, y[j][7] * inv);
        *(GAS v2u*)(orow8 + (lane + 64 * j) * 8) = o; }
}

#define KSWZ(row, colB) ((row) * 256 + ((colB) ^ (((row) & 7) << 4)))
constexpr int ATT_TILE = 16384;
__device__ __forceinline__ int v_st(int k, int c) { const int kk = (k & ~0xC) | ((k & 4) << 1) | ((k & 8) >> 1); return ((kk >> 3) * 4 + (c >> 5)) * 512 + ((kk & 7) * 32 + (c & 31)) * 2; }
__device__ __forceinline__ int v_rd_base(int lane) { return ((lane & 3) << 3) | (((lane >> 2) & 3) << 6) | (((lane >> 4) & 1) << 5) | (((lane >> 5) & 1) << 8); }
constexpr int v_rd_off(int d0, int ks, int half) { return d0 * 512 + ks * 4096 + half * 2048; }
__device__ __forceinline__ int crow(int r, int hi) { return (r & 3) + 8 * (r >> 2) + 4 * hi; }
__device__ __forceinline__ unsigned cvtpk(float lo, float hi) { unsigned r; asm volatile("v_cvt_pk_bf16_f32 %0, %1, %2" : "=v"(r) : "v"(lo), "v"(hi)); return r; }

__device__ __forceinline__ void qkt64(f32x16& p0, f32x16& p1, const LAS char* Kt, int r32, int hi, const bf16x8* qr) {
    p0 = f32x16{}; p1 = f32x16{};
    const LAS char* kb[4];
#pragma unroll
    for (int dd = 0; dd < 4; ++dd) kb[dd] = Kt + KSWZ(r32, (dd * 16 + hi * 8) * 2);
#pragma unroll
    for (int d0 = 0; d0 < 8; ++d0) { const LAS char* a = kb[d0 & 3] + (d0 >> 2) * 128;
        const bf16x8 b0 = *(const LAS bf16x8*)a;
        const bf16x8 b1 = *(const LAS bf16x8*)(a + 32 * 256);
        p0 = __builtin_amdgcn_mfma_f32_32x32x16_bf16(b0, qr[d0], p0, 0, 0, 0);
        p1 = __builtin_amdgcn_mfma_f32_32x32x16_bf16(b1, qr[d0], p1, 0, 0, 0); }
}
__device__ __forceinline__ void qkt32(f32x16& p0, const LAS char* Kt, int r32, int hi, const bf16x8* qr) {
    p0 = f32x16{};
#pragma unroll
    for (int d0 = 0; d0 < 8; ++d0) { const bf16x8 b0 = *(const LAS bf16x8*)(Kt + KSWZ(r32, (d0 * 16 + hi * 8) * 2));
        p0 = __builtin_amdgcn_mfma_f32_32x32x16_bf16(b0, qr[d0], p0, 0, 0, 0); }
}
__device__ __forceinline__ void pack_p(const f32x16& p0, const f32x16& p1, bf16x8& pa0, bf16x8& pa1, bf16x8& pa2, bf16x8& pa3) {
#define PK4(P, B_, OUT) do { unsigned a0 = cvtpk(P[B_+0], P[B_+1]), a1 = cvtpk(P[B_+2], P[B_+3]);                          \
        unsigned b0 = cvtpk(P[B_+4], P[B_+5]), b1 = cvtpk(P[B_+6], P[B_+7]);                                             \
        auto r0 = __builtin_amdgcn_permlane32_swap(a0, b0, false, false); auto r1 = __builtin_amdgcn_permlane32_swap(a1, b1, false, false); \
        v4u w = {r0[0], r1[0], r0[1], r1[1]}; OUT = __builtin_bit_cast(bf16x8, w); } while (0)
    PK4(p0, 0, pa0); PK4(p0, 8, pa1); PK4(p1, 0, pa2); PK4(p1, 8, pa3);
#undef PK4
}
__device__ __forceinline__ void pv64(f32x16* o, int vb0, bf16x8 pa0, bf16x8 pa1, bf16x8 pa2, bf16x8 pa3) {
#define TRRD(dst, off) asm volatile("ds_read_b64_tr_b16 %0, %1 offset:%2" : "=&v"(dst) : "v"(vb0), "i"(off) : "memory")
#define PV_D0(d0) do { s16x4 l0, l1, l2, l3, h0, h1, h2, h3; constexpr int b_ = v_rd_off(d0, 0, 0); \
        TRRD(l0, b_); TRRD(h0, b_ + 2048); TRRD(l1, b_ + 4096); TRRD(h1, b_ + 6144); TRRD(l2, b_ + 8192); TRRD(h2, b_ + 10240); TRRD(l3, b_ + 12288); TRRD(h3, b_ + 14336); \
        asm volatile("s_waitcnt lgkmcnt(0)" ::: "memory"); SBAR();   \
        o[d0] = __builtin_amdgcn_mfma_f32_32x32x16_bf16(pa0, (bf16x8){l0[0], l0[1], l0[2], l0[3], h0[0], h0[1], h0[2], h0[3]}, o[d0], 0, 0, 0);   \
        o[d0] = __builtin_amdgcn_mfma_f32_32x32x16_bf16(pa1, (bf16x8){l1[0], l1[1], l1[2], l1[3], h1[0], h1[1], h1[2], h1[3]}, o[d0], 0, 0, 0);   \
        o[d0] = __builtin_amdgcn_mfma_f32_32x32x16_bf16(pa2, (bf16x8){l2[0], l2[1], l2[2], l2[3], h2[0], h2[1], h2[2], h2[3]}, o[d0], 0, 0, 0);   \
        o[d0] = __builtin_amdgcn_mfma_f32_32x32x16_bf16(pa3, (bf16x8){l3[0], l3[1], l3[2], l3[3], h3[0], h3[1], h3[2], h3[3]}, o[d0], 0, 0, 0); } while (0)
    PV_D0(0); PV_D0(1); PV_D0(2); PV_D0(3);
#undef PV_D0
#undef TRRD
}
__device__ __forceinline__ void store_o(const f32x16* o, const float* scl, bf16* Ow, int ld, int r32, int hi) {
#pragma unroll
    for (int r = 0; r < 16; ++r) { const int orow = crow(r, hi);
#pragma unroll
        for (int d0 = 0; d0 < 4; ++d0) { const float v = o[d0][r] * scl[r]; const float vn = pg8::dpp_f<0xB1>(v);
            if ((r32 & 1) == 0) *(GAS unsigned*)(Ow + (size_t)orow * ld + d0 * 32 + r32) = pk2(v, vn); } }
}
__device__ __forceinline__ void softmax_step(f32x16& p0, f32x16& p1, float& m, float& l, f32x16* o, LAS float* al_l, int r32, int hi) {
    float pmax = p0[0];
#pragma unroll
    for (int r = 1; r < 16; ++r) pmax = fmaxf(pmax, p0[r]);
#pragma unroll
    for (int r = 0; r < 16; ++r) pmax = fmaxf(pmax, p1[r]);
    pmax = pair_max(pmax);
    const float mn = fmaxf(m, pmax);
    const float alpha = __builtin_amdgcn_exp2f(m - mn); m = mn;
    float ps = 0.f;
#pragma unroll
    for (int r = 0; r < 16; ++r) { p0[r] = __builtin_amdgcn_exp2f(p0[r] - mn); ps += p0[r]; }
#pragma unroll
    for (int r = 0; r < 16; ++r) { p1[r] = __builtin_amdgcn_exp2f(p1[r] - mn); ps += p1[r]; }
    ps = pair_sum(ps);
    l = l * alpha + ps;
    if (__any(alpha < 1.f)) {
        if (hi == 0) al_l[r32] = alpha;
        LDS_WAIT();
#pragma unroll
        for (int r = 0; r < 16; ++r) { const float a = al_l[crow(r, hi)];
#pragma unroll
            for (int d = 0; d < 4; ++d) o[d][r] *= a; }
        LDS_WAIT();
    }
}
struct KVStage { bf16x8 k0, k1, v0, v1; };
__device__ __forceinline__ void kv_load(KVStage& s, const bf16* Kp, const bf16* Vp, int ld, int kb0, int sr, int sc) {
    const bf16* kq = Kp + (size_t)kb0 * ld; const bf16* vq = Vp + (size_t)kb0 * ld;
    const unsigned o0 = (unsigned)(sr * ld + sc), o1 = o0 + 32u * (unsigned)ld;
    s.k0 = *(const GAS bf16x8*)(kq + o0); s.k1 = *(const GAS bf16x8*)(kq + o1);
    s.v0 = *(const GAS bf16x8*)(vq + o0); s.v1 = *(const GAS bf16x8*)(vq + o1);
}
__device__ __forceinline__ void kv_write(const KVStage& s, LAS char* K_lds, LAS char* V_lds, int sr, int sc) {
    const int kws = KSWZ(sr, sc * 2);
    *(LAS bf16x8*)(K_lds + kws) = s.k0; *(LAS bf16x8*)(K_lds + kws + 32 * 256) = s.k1;
    *(LAS bf16x8*)(V_lds + v_st(sr, sc)) = s.v0; *(LAS bf16x8*)(V_lds + v_st(32 + sr, sc)) = s.v1;
}

__device__ __forceinline__ void moba_unit(LAS char* lds, const bf16* PROJ, const bf16* KMEAN, bf16* AO, int b, int h, int own, float thrB, int tid) {
    const int wid = __builtin_amdgcn_readfirstlane(tid >> 6), lane = tid & 63, r32 = lane & 31, hi = lane >> 5;
    const bool late = wid >= 4;
    LAS float* al_l = (LAS float*)(lds + 6 * ATT_TILE) + wid * 64;
    const int sr = tid >> 4, sc = (tid & 15) * 8;
    const bf16* Kp = PROJ + (size_t)((1 * 64 + b * 16 + h) * T) * 128; const bf16* Vp = PROJ + (size_t)((2 * 64 + b * 16 + h) * T) * 128;
    const int tq = own * 256 + wid * 32 + r32;
    const float slope = exp2f(-0.5f * (float)(h + 1));
    int t_lo = 0; { const float lim = (float)(own * 256 - 63) - thrB / slope; if (lim > 0.f) t_lo = (int)ceilf(lim * (1.f / 64.f)); if (t_lo > 4 * own) t_lo = 4 * own; }
    t_lo = __builtin_amdgcn_readfirstlane(t_lo);
    const int NT = 4 * (own + 1) - t_lo;
    bf16x8 qr[8];
    { const bf16* qp = PROJ + ((size_t)((0 * 64 + b * 16 + h) * T) + tq) * 128 + hi * 8;
#pragma unroll
      for (int d0 = 0; d0 < 8; ++d0) qr[d0] = *(const GAS bf16x8*)(qp + d0 * 16); }
    KVStage st; kv_load(st, Kp, Vp, 128, t_lo * 64, sr, sc);
    __syncthreads();
    { const int row = tid >> 4, chk = tid & 15; bf16x8 v = {0, 0, 0, 0, 0, 0, 0, 0};
      if (row < 16) v = *(const GAS bf16x8*)(KMEAN + ((size_t)((b * 16 + h) * 16 + row)) * 128 + chk * 8);
      *(LAS bf16x8*)(lds + 5 * ATT_TILE + KSWZ(row, chk * 16)) = v; }
    kv_write(st, lds + ATT_TILE, lds, sr, sc);
    if (NT > 1) kv_load(st, Kp, Vp, 128, (t_lo + 1) * 64, sr, sc);
    __syncthreads();
    unsigned sel = 0u;
    { f32x16 g0; qkt32(g0, lds + 5 * ATT_TILE, r32, hi, qr);
      float gate[16];
#pragma unroll
      for (int k = 0; k < 8; ++k) { const int nA = (k & 3) + 8 * (k >> 2), nB = nA + 4; const float mine = g0[k], oth = pair_other(mine, hi);
          gate[nA] = hi ? oth : mine; gate[nB] = hi ? mine : oth; }
      if (own <= 3) sel = (1u << own) - 1u;
      else {
#pragma unroll
          for (int pick = 0; pick < 3; ++pick) { float best = -3.0e38f; int bi = 0;
#pragma unroll
              for (int n = 0; n < 16; ++n) { const bool ok = (n < own) && !((sel >> n) & 1u) && (gate[n] > best); best = ok ? gate[n] : best; bi = ok ? n : bi; }
              sel |= 1u << bi; } } }
    const float C2 = 0.08838834764831845f * 1.4426950408889634f, SL2 = slope * 1.4426950408889634f, SL8 = 8.f * SL2, SL32 = 32.f * SL2;
    const float NEG = -__builtin_inff();
    float m = -1e30f, l = 0.f; f32x16 o[4] = {};
    bf16x8 pa0 = {0, 0, 0, 0, 0, 0, 0, 0}, pa1 = pa0, pa2 = pa0, pa3 = pa0; bool pend = false; int vprev = 0;
    int cur = 0;
    for (int t = 0; t < NT; ++t) {
        const int tt = t_lo + t; const int nxt = cur == 2 ? 0 : cur + 1;
        LAS char* Vc = lds + cur * 2 * ATT_TILE; LAS char* Kc = Vc + ATT_TILE;
        if (t + 1 < NT) { kv_write(st, lds + nxt * 2 * ATT_TILE + ATT_TILE, lds + nxt * 2 * ATT_TILE, sr, sc);
            if (t + 2 < NT) kv_load(st, Kp, Vp, 128, (tt + 2) * 64, sr, sc); }
        if (late && pend) pv64(o, vprev, pa0, pa1, pa2, pa3);
        const int n = tt >> 2; const bool past = n < own;
        const bool mysel = (sel >> n) & 1u;
        const bool act = past ? (__ballot(mysel) != 0ull) : ((tt & 3) * 64 <= wid * 32 + 31);
        if (act) {
            f32x16 p0, p1; qkt64(p0, p1, Kc, r32, hi, qr);
            const int dq = tq - tt * 64 - 4 * hi;
            { float xq_ = (!past || mysel) ? -SL2 * (float)dq : NEG;
#pragma unroll
              for (int q = 0; q < 4; ++q) { float y = xq_;
#pragma unroll
                  for (int i = 0; i < 4; ++i) { const int r = 4 * q + i; p0[r] = fmaf(p0[r], C2, y); p1[r] = fmaf(p1[r], C2, y + SL32); y += SL2; }
                  xq_ += SL8; } }
            if (!past && (tt & 3) * 64 + 63 > wid * 32) {
#pragma unroll
                for (int r = 0; r < 16; ++r) { const int c = (r & 3) + 8 * (r >> 2); p0[r] = (dq >= c) ? p0[r] : NEG; p1[r] = (dq >= c + 32) ? p1[r] : NEG; } }
            softmax_step(p0, p1, m, l, o, al_l, r32, hi);
            pack_p(p0, p1, pa0, pa1, pa2, pa3);
            if (!late) pv64(o, (int)(unsigned)(uintptr_t)Vc + v_rd_base(lane), pa0, pa1, pa2, pa3);
        }
        pend = act; vprev = (int)(unsigned)(uintptr_t)Vc + v_rd_base(lane);
        cur = nxt;
        __syncthreads();
    }
    if (late && pend) pv64(o, vprev, pa0, pa1, pa2, pa3);
    if (hi == 0) al_l[r32] = l; LDS_WAIT();
    float rli[16];
#pragma unroll
    for (int r = 0; r < 16; ++r) rli[r] = 1.0f / al_l[crow(r, hi)];
    LDS_WAIT();
    store_o(o, rli, AO + (size_t)(b * T + own * 256 + wid * 32) * LDAO + h * 128, LDAO, r32, hi);
}

__device__ __forceinline__ void sb_unit(LAS char* lds, const bf16* PROJ, bf16* AO, int b, int h, int blk, int tid) {
    const int wid = __builtin_amdgcn_readfirstlane(tid >> 6), lane = tid & 63, r32 = lane & 31, hi = lane >> 5;
    LAS char* V_lds = lds; LAS char* K_lds = lds + ATT_TILE; LAS unsigned* flags = (LAS unsigned*)(lds + 2 * ATT_TILE + 2048);
    const int sr = tid >> 4, sc = (tid & 15) * 8;
    const bf16* Kp = PROJ + (size_t)((4 * 64 + b * 16 + h) * T) * 128; const bf16* Vp = PROJ + (size_t)((5 * 64 + b * 16 + h) * T) * 128;
    const int tq = blk * 256 + wid * 32 + r32;
    bf16x8 qr[8];
    { const bf16* qp = PROJ + ((size_t)((3 * 64 + b * 16 + h) * T) + tq) * 128 + hi * 8;
#pragma unroll
      for (int d0 = 0; d0 < 8; ++d0) qr[d0] = *(const GAS bf16x8*)(qp + d0 * 16); }
    int jt = blk * 4 + 3;
    KVStage st; kv_load(st, Kp, Vp, 128, jt * 64, sr, sc);
    float R = 1.f; f32x16 o[4] = {};
    const int vb0 = (int)(unsigned)(uintptr_t)V_lds + v_rd_base(lane);
    const float SL2E = 0.08838834764831845f * 1.4426950408889634f;
    bool wdone = false;
    for (;;) {
        __syncthreads();
        kv_write(st, K_lds, V_lds, sr, sc);
        __syncthreads();
        if (jt > 0) kv_load(st, Kp, Vp, 128, (jt - 1) * 64, sr, sc);
        const bool started = jt * 64 <= blk * 256 + wid * 32 + 30;
        if (started && !wdone) {
            const int dq = tq - jt * 64 - 4 * hi;
            const bool allpast = jt * 64 + 63 < blk * 256 + wid * 32;
            bf16x8 pa[4]; float acc = 1.f;
#pragma unroll
            for (int ph = 1; ph >= 0; --ph) {
                f32x16 z; qkt32(z, K_lds + ph * 32 * 256, r32, hi, qr);
                f32x16 om; const int dqh = dq - 32 * ph;
#pragma unroll
                for (int r = 0; r < 16; ++r) { const float om_ = __builtin_amdgcn_rcpf(1.0f + __builtin_amdgcn_exp2f(z[r] * SL2E)); om[r] = om_; z[r] = 1.0f - om_; }
                if (!allpast) {
#pragma unroll
                    for (int r = 0; r < 16; ++r) { const int c = (r & 3) + 8 * (r >> 2); const bool strict = dqh > c; om[r] = strict ? om[r] : 1.0f; z[r] = strict ? z[r] : 0.f; } }
#pragma unroll
                for (int q = 3; q >= 0; --q) { const float mine = (om[4 * q] * om[4 * q + 1]) * (om[4 * q + 2] * om[4 * q + 3]);
                    unsigned a_, b_; pair_get(__float_as_uint(mine), a_, b_); const float s_lo = __uint_as_float(a_), s_hi = __uint_as_float(b_);
                    const float bs = R * (hi ? acc : (acc * s_hi)); acc *= s_hi * s_lo;
                    const float e3 = bs, e2 = bs * om[4 * q + 3], e1 = e2 * om[4 * q + 2], e0 = e1 * om[4 * q + 1];
                    z[4 * q + 0] *= e0; z[4 * q + 1] *= e1; z[4 * q + 2] *= e2; z[4 * q + 3] *= e3; }
#define PK4(P, B_, OUT) do { unsigned a0 = cvtpk(P[B_+0], P[B_+1]), a1 = cvtpk(P[B_+2], P[B_+3]);                          \
        unsigned b0 = cvtpk(P[B_+4], P[B_+5]), b1 = cvtpk(P[B_+6], P[B_+7]);                                             \
        auto r0 = __builtin_amdgcn_permlane32_swap(a0, b0, false, false); auto r1 = __builtin_amdgcn_permlane32_swap(a1, b1, false, false); \
        v4u w = {r0[0], r1[0], r0[1], r1[1]}; OUT = __builtin_bit_cast(bf16x8, w); } while (0)
                PK4(z, 0, pa[2 * ph]); PK4(z, 8, pa[2 * ph + 1]);
#undef PK4
            }
            R *= acc;
            pv64(o, vb0, pa[0], pa[1], pa[2], pa[3]);
            wdone = __all(R < 1e-36f);
        }
        if (lane == 0) flags[wid] = wdone ? 1u : 0u;
        __syncthreads();
        bool alld = true;
#pragma unroll
        for (int w = 0; w < 8; ++w) alld = alld && (flags[w] != 0u);
        if (jt == 0 || alld) break;
        --jt;
    }
    float one[16];
#pragma unroll
    for (int r = 0; r < 16; ++r) one[r] = 1.0f;
    store_o(o, one, AO + (size_t)(b * T + blk * 256 + wid * 32) * LDAO + 2048 + h * 128, LDAO, r32, hi);
}

__device__ __forceinline__ void xattn_unit(LAS char* lds, const bf16* XQ, const bf16* KVMEM, const float* gq, const float* gk, bf16* XO, int b, int xh, int blk, int tid) {
    const int wid = __builtin_amdgcn_readfirstlane(tid >> 6), lane = tid & 63, r32 = lane & 31, hi = lane >> 5;
    LAS char* V_lds = lds; LAS char* K_lds = lds + ATT_TILE; LAS float* al_l = (LAS float*)(lds + 2 * ATT_TILE) + wid * 64;
    const int sr = tid >> 4, sc = (tid & 15) * 8;
    const bf16* Kp = KVMEM + (size_t)(b * NMEM) * 1024 + xh * 128; const bf16* Vp = KVMEM + (size_t)(b * NMEM) * 1024 + 512 + xh * 128;
    const int row = b * T + blk * 256 + wid * 32 + r32;
    bf16x8 qr[8];
    { const bf16* qp = XQ + (size_t)row * XW + xh * 128 + hi * 8;
      v4u raw[8]; float ss = 0.f;
#pragma unroll
      for (int d0 = 0; d0 < 8; ++d0) { raw[d0] = *(const GAS v4u*)(qp + d0 * 16);
          const float x[8] = {bflo(raw[d0].x), bfhi(raw[d0].x), bflo(raw[d0].y), bfhi(raw[d0].y), bflo(raw[d0].z), bfhi(raw[d0].z), bflo(raw[d0].w), bfhi(raw[d0].w)};
#pragma unroll
          for (int k = 0; k < 8; ++k) ss += x[k] * x[k]; }
      ss = pair_sum(ss);
      const float r = 1.0f / sqrtf(ss * (1.f / 128.f) + RMS_EPS);
#pragma unroll
      for (int d0 = 0; d0 < 8; ++d0) { const float* g = gq + d0 * 16 + hi * 8; const f32x4 ga = *(const GAS f32x4*)g, gb = *(const GAS f32x4*)(g + 4);
          v4u w; w.x = pk2(bflo(raw[d0].x) * r * ga.x, bfhi(raw[d0].x) * r * ga.y); w.y = pk2(bflo(raw[d0].y) * r * ga.z, bfhi(raw[d0].y) * r * ga.w);
          w.z = pk2(bflo(raw[d0].z) * r * gb.x, bfhi(raw[d0].z) * r * gb.y); w.w = pk2(bflo(raw[d0].w) * r * gb.z, bfhi(raw[d0].w) * r * gb.w);
          qr[d0] = __builtin_bit_cast(bf16x8, w); } }
    float gkk[8];
#pragma unroll
    for (int j = 0; j < 8; ++j) gkk[j] = gk[sc + j];
    const float C2 = 0.08838834764831845f * 1.4426950408889634f;
    float m = -1e30f, l = 0.f; f32x16 o[4] = {};
    const int vb0 = (int)(unsigned)(uintptr_t)V_lds + v_rd_base(lane);
    KVStage st; kv_load(st, Kp, Vp, 1024, 0, sr, sc);
    for (int t = 0; t < 4; ++t) {
        { v4u w0 = __builtin_bit_cast(v4u, st.k0), w1 = __builtin_bit_cast(v4u, st.k1);
          float x0[8] = {bflo(w0.x), bfhi(w0.x), bflo(w0.y), bfhi(w0.y), bflo(w0.z), bfhi(w0.z), bflo(w0.w), bfhi(w0.w)};
          float x1[8] = {bflo(w1.x), bfhi(w1.x), bflo(w1.y), bfhi(w1.y), bflo(w1.z), bfhi(w1.z), bflo(w1.w), bfhi(w1.w)};
          float s0 = 0.f, s1 = 0.f;
#pragma unroll
          for (int k = 0; k < 8; ++k) { s0 += x0[k] * x0[k]; s1 += x1[k] * x1[k]; }
          s0 += __shfl_xor(s0, 1); s0 += __shfl_xor(s0, 2); s0 += __shfl_xor(s0, 4); s0 += __shfl_xor(s0, 8);
          s1 += __shfl_xor(s1, 1); s1 += __shfl_xor(s1, 2); s1 += __shfl_xor(s1, 4); s1 += __shfl_xor(s1, 8);
          const float r0 = 1.0f / sqrtf(s0 * (1.f / 128.f) + RMS_EPS), r1 = 1.0f / sqrtf(s1 * (1.f / 128.f) + RMS_EPS);
          w0.x = pk2(x0[0] * r0 * gkk[0], x0[1] * r0 * gkk[1]); w0.y = pk2(x0[2] * r0 * gkk[2], x0[3] * r0 * gkk[3]); w0.z = pk2(x0[4] * r0 * gkk[4], x0[5] * r0 * gkk[5]); w0.w = pk2(x0[6] * r0 * gkk[6], x0[7] * r0 * gkk[7]);
          w1.x = pk2(x1[0] * r1 * gkk[0], x1[1] * r1 * gkk[1]); w1.y = pk2(x1[2] * r1 * gkk[2], x1[3] * r1 * gkk[3]); w1.z = pk2(x1[4] * r1 * gkk[4], x1[5] * r1 * gkk[5]); w1.w = pk2(x1[6] * r1 * gkk[6], x1[7] * r1 * gkk[7]);
          st.k0 = __builtin_bit_cast(bf16x8, w0); st.k1 = __builtin_bit_cast(bf16x8, w1); }
        __syncthreads();
        kv_write(st, K_lds, V_lds, sr, sc);
        __syncthreads();
        if (t + 1 < 4) kv_load(st, Kp, Vp, 1024, (t + 1) * 64, sr, sc);
        f32x16 p0, p1; qkt64(p0, p1, K_lds, r32, hi, qr);
#pragma unroll
        for (int r = 0; r < 16; ++r) { p0[r] *= C2; p1[r] *= C2; }
        softmax_step(p0, p1, m, l, o, al_l, r32, hi);
        bf16x8 pa0, pa1, pa2, pa3; pack_p(p0, p1, pa0, pa1, pa2, pa3);
        pv64(o, vb0, pa0, pa1, pa2, pa3);
    }
    if (hi == 0) al_l[r32] = l; LDS_WAIT();
    float rli[16];
#pragma unroll
    for (int r = 0; r < 16; ++r) rli[r] = 1.0f / al_l[crow(r, hi)];
    LDS_WAIT();
    store_o(o, rli, XO + (size_t)(b * T + blk * 256 + wid * 32) * LDXO + xh * 128, LDXO, r32, hi);
    __syncthreads();
}

__device__ __forceinline__ unsigned f2ord(float f) { const unsigned u = __float_as_uint(f); return u ^ ((u >> 31) ? 0xffffffffu : 0x80000000u); }
__device__ __forceinline__ float ord2f(unsigned k) { return __uint_as_float(k ^ ((k >> 31) ? 0x80000000u : 0xffffffffu)); }
__device__ __forceinline__ void sort16_desc(unsigned (&x)[16]) {
    { const unsigned hi_ = x[0] > x[1] ? x[0] : x[1], lo_ = x[0] > x[1] ? x[1] : x[0]; x[0] = hi_; x[1] = lo_; }
    { const unsigned hi_ = x[2] > x[3] ? x[2] : x[3], lo_ = x[2] > x[3] ? x[3] : x[2]; x[2] = lo_; x[3] = hi_; }
    { const unsigned hi_ = x[4] > x[5] ? x[4] : x[5], lo_ = x[4] > x[5] ? x[5] : x[4]; x[4] = hi_; x[5] = lo_; }
    { const unsigned hi_ = x[6] > x[7] ? x[6] : x[7], lo_ = x[6] > x[7] ? x[7] : x[6]; x[6] = lo_; x[7] = hi_; }
    { const unsigned hi_ = x[8] > x[9] ? x[8] : x[9], lo_ = x[8] > x[9] ? x[9] : x[8]; x[8] = hi_; x[9] = lo_; }
    { const unsigned hi_ = x[10] > x[11] ? x[10] : x[11], lo_ = x[10] > x[11] ? x[11] : x[10]; x[10] = lo_; x[11] = hi_; }
    { const unsigned hi_ = x[12] > x[13] ? x[12] : x[13], lo_ = x[12] > x[13] ? x[13] : x[12]; x[12] = hi_; x[13] = lo_; }
    { const unsigned hi_ = x[14] > x[15] ? x[14] : x[15], lo_ = x[14] > x[15] ? x[15] : x[14]; x[14] = lo_; x[15] = hi_; }
    { const unsigned hi_ = x[0] > x[2] ? x[0] : x[2], lo_ = x[0] > x[2] ? x[2] : x[0]; x[0] = hi_; x[2] = lo_; }
    { const unsigned hi_ = x[1] > x[3] ? x[1] : x[3], lo_ = x[1] > x[3] ? x[3] : x[1]; x[1] = hi_; x[3] = lo_; }
    { const unsigned hi_ = x[4] > x[6] ? x[4] : x[6], lo_ = x[4] > x[6] ? x[6] : x[4]; x[4] = lo_; x[6] = hi_; }
    { const unsigned hi_ = x[5] > x[7] ? x[5] : x[7], lo_ = x[5] > x[7] ? x[7] : x[5]; x[5] = lo_; x[7] = hi_; }
    { const unsigned hi_ = x[8] > x[10] ? x[8] : x[10], lo_ = x[8] > x[10] ? x[10] : x[8]; x[8] = hi_; x[10] = lo_; }
    { const unsigned hi_ = x[9] > x[11] ? x[9] : x[11], lo_ = x[9] > x[11] ? x[11] : x[9]; x[9] = hi_; x[11] = lo_; }
    { const unsigned hi_ = x[12] > x[14] ? x[12] : x[14], lo_ = x[12] > x[14] ? x[14] : x[12]; x[12] = lo_; x[14] = hi_; }
    { const unsigned hi_ = x[13] > x[15] ? x[13] : x[15], lo_ = x[13] > x[15] ? x[15] : x[13]; x[13] = lo_; x[15] = hi_; }
    { const unsigned hi_ = x[0] > x[1] ? x[0] : x[1], lo_ = x[0] > x[1] ? x[1] : x[0]; x[0] = hi_; x[1] = lo_; }
    { const unsigned hi_ = x[2] > x[3] ? x[2] : x[3], lo_ = x[2] > x[3] ? x[3] : x[2]; x[2] = hi_; x[3] = lo_; }
    { const unsigned hi_ = x[4] > x[5] ? x[4] : x[5], lo_ = x[4] > x[5] ? x[5] : x[4]; x[4] = lo_; x[5] = hi_; }
    { const unsigned hi_ = x[6] > x[7] ? x[6] : x[7], lo_ = x[6] > x[7] ? x[7] : x[6]; x[6] = lo_; x[7] = hi_; }
    { const unsigned hi_ = x[8] > x[9] ? x[8] : x[9], lo_ = x[8] > x[9] ? x[9] : x[8]; x[8] = hi_; x[9] = lo_; }
    { const unsigned hi_ = x[10] > x[11] ? x[10] : x[11], lo_ = x[10] > x[11] ? x[11] : x[10]; x[10] = hi_; x[11] = lo_; }
    { const unsigned hi_ = x[12] > x[13] ? x[12] : x[13], lo_ = x[12] > x[13] ? x[13] : x[12]; x[12] = lo_; x[13] = hi_; }
    { const unsigned hi_ = x[14] > x[15] ? x[14] : x[15], lo_ = x[14] > x[15] ? x[15] : x[14]; x[14] = lo_; x[15] = hi_; }
    { const unsigned hi_ = x[0] > x[4] ? x[0] : x[4], lo_ = x[0] > x[4] ? x[4] : x[0]; x[0] = hi_; x[4] = lo_; }
    { const unsigned hi_ = x[1] > x[5] ? x[1] : x[5], lo_ = x[1] > x[5] ? x[5] : x[1]; x[1] = hi_; x[5] = lo_; }
    { const unsigned hi_ = x[2] > x[6] ? x[2] : x[6], lo_ = x[2] > x[6] ? x[6] : x[2]; x[2] = hi_; x[6] = lo_; }
    { const unsigned hi_ = x[3] > x[7] ? x[3] : x[7], lo_ = x[3] > x[7] ? x[7] : x[3]; x[3] = hi_; x[7] = lo_; }
    { const unsigned hi_ = x[8] > x[12] ? x[8] : x[12], lo_ = x[8] > x[12] ? x[12] : x[8]; x[8] = lo_; x[12] = hi_; }
    { const unsigned hi_ = x[9] > x[13] ? x[9] : x[13], lo_ = x[9] > x[13] ? x[13] : x[9]; x[9] = lo_; x[13] = hi_; }
    { const unsigned hi_ = x[10] > x[14] ? x[10] : x[14], lo_ = x[10] > x[14] ? x[14] : x[10]; x[10] = lo_; x[14] = hi_; }
    { const unsigned hi_ = x[11] > x[15] ? x[11] : x[15], lo_ = x[11] > x[15] ? x[15] : x[11]; x[11] = lo_; x[15] = hi_; }
    { const unsigned hi_ = x[0] > x[2] ? x[0] : x[2], lo_ = x[0] > x[2] ? x[2] : x[0]; x[0] = hi_; x[2] = lo_; }
    { const unsigned hi_ = x[1] > x[3] ? x[1] : x[3], lo_ = x[1] > x[3] ? x[3] : x[1]; x[1] = hi_; x[3] = lo_; }
    { const unsigned hi_ = x[4] > x[6] ? x[4] : x[6], lo_ = x[4] > x[6] ? x[6] : x[4]; x[4] = hi_; x[6] = lo_; }
    { const unsigned hi_ = x[5] > x[7] ? x[5] : x[7], lo_ = x[5] > x[7] ? x[7] : x[5]; x[5] = hi_; x[7] = lo_; }
    { const unsigned hi_ = x[8] > x[10] ? x[8] : x[10], lo_ = x[8] > x[10] ? x[10] : x[8]; x[8] = lo_; x[10] = hi_; }
    { const unsigned hi_ = x[9] > x[11] ? x[9] : x[11], lo_ = x[9] > x[11] ? x[11] : x[9]; x[9] = lo_; x[11] = hi_; }
    { const unsigned hi_ = x[12] > x[14] ? x[12] : x[14], lo_ = x[12] > x[14] ? x[14] : x[12]; x[12] = lo_; x[14] = hi_; }
    { const unsigned hi_ = x[13] > x[15] ? x[13] : x[15], lo_ = x[13] > x[15] ? x[15] : x[13]; x[13] = lo_; x[15] = hi_; }
    { const unsigned hi_ = x[0] > x[1] ? x[0] : x[1], lo_ = x[0] > x[1] ? x[1] : x[0]; x[0] = hi_; x[1] = lo_; }
    { const unsigned hi_ = x[2] > x[3] ? x[2] : x[3], lo_ = x[2] > x[3] ? x[3] : x[2]; x[2] = hi_; x[3] = lo_; }
    { const unsigned hi_ = x[4] > x[5] ? x[4] : x[5], lo_ = x[4] > x[5] ? x[5] : x[4]; x[4] = hi_; x[5] = lo_; }
    { const unsigned hi_ = x[6] > x[7] ? x[6] : x[7], lo_ = x[6] > x[7] ? x[7] : x[6]; x[6] = hi_; x[7] = lo_; }
    { const unsigned hi_ = x[8] > x[9] ? x[8] : x[9], lo_ = x[8] > x[9] ? x[9] : x[8]; x[8] = lo_; x[9] = hi_; }
    { const unsigned hi_ = x[10] > x[11] ? x[10] : x[11], lo_ = x[10] > x[11] ? x[11] : x[10]; x[10] = lo_; x[11] = hi_; }
    { const unsigned hi_ = x[12] > x[13] ? x[12] : x[13], lo_ = x[12] > x[13] ? x[13] : x[12]; x[12] = lo_; x[13] = hi_; }
    { const unsigned hi_ = x[14] > x[15] ? x[14] : x[15], lo_ = x[14] > x[15] ? x[15] : x[14]; x[14] = lo_; x[15] = hi_; }
    { const unsigned hi_ = x[0] > x[8] ? x[0] : x[8], lo_ = x[0] > x[8] ? x[8] : x[0]; x[0] = hi_; x[8] = lo_; }
    { const unsigned hi_ = x[1] > x[9] ? x[1] : x[9], lo_ = x[1] > x[9] ? x[9] : x[1]; x[1] = hi_; x[9] = lo_; }
    { const unsigned hi_ = x[2] > x[10] ? x[2] : x[10], lo_ = x[2] > x[10] ? x[10] : x[2]; x[2] = hi_; x[10] = lo_; }
    { const unsigned hi_ = x[3] > x[11] ? x[3] : x[11], lo_ = x[3] > x[11] ? x[11] : x[3]; x[3] = hi_; x[11] = lo_; }
    { const unsigned hi_ = x[4] > x[12] ? x[4] : x[12], lo_ = x[4] > x[12] ? x[12] : x[4]; x[4] = hi_; x[12] = lo_; }
    { const unsigned hi_ = x[5] > x[13] ? x[5] : x[13], lo_ = x[5] > x[13] ? x[13] : x[5]; x[5] = hi_; x[13] = lo_; }
    { const unsigned hi_ = x[6] > x[14] ? x[6] : x[14], lo_ = x[6] > x[14] ? x[14] : x[6]; x[6] = hi_; x[14] = lo_; }
    { const unsigned hi_ = x[7] > x[15] ? x[7] : x[15], lo_ = x[7] > x[15] ? x[15] : x[7]; x[7] = hi_; x[15] = lo_; }
    { const unsigned hi_ = x[0] > x[4] ? x[0] : x[4], lo_ = x[0] > x[4] ? x[4] : x[0]; x[0] = hi_; x[4] = lo_; }
    { const unsigned hi_ = x[1] > x[5] ? x[1] : x[5], lo_ = x[1] > x[5] ? x[5] : x[1]; x[1] = hi_; x[5] = lo_; }
    { const unsigned hi_ = x[2] > x[6] ? x[2] : x[6], lo_ = x[2] > x[6] ? x[6] : x[2]; x[2] = hi_; x[6] = lo_; }
    { const unsigned hi_ = x[3] > x[7] ? x[3] : x[7], lo_ = x[3] > x[7] ? x[7] : x[3]; x[3] = hi_; x[7] = lo_; }
    { const unsigned hi_ = x[8] > x[12] ? x[8] : x[12], lo_ = x[8] > x[12] ? x[12] : x[8]; x[8] = hi_; x[12] = lo_; }
    { const unsigned hi_ = x[9] > x[13] ? x[9] : x[13], lo_ = x[9] > x[13] ? x[13] : x[9]; x[9] = hi_; x[13] = lo_; }
    { const unsigned hi_ = x[10] > x[14] ? x[10] : x[14], lo_ = x[10] > x[14] ? x[14] : x[10]; x[10] = hi_; x[14] = lo_; }
    { const unsigned hi_ = x[11] > x[15] ? x[11] : x[15], lo_ = x[11] > x[15] ? x[15] : x[11]; x[11] = hi_; x[15] = lo_; }
    { const unsigned hi_ = x[0] > x[2] ? x[0] : x[2], lo_ = x[0] > x[2] ? x[2] : x[0]; x[0] = hi_; x[2] = lo_; }
    { const unsigned hi_ = x[1] > x[3] ? x[1] : x[3], lo_ = x[1] > x[3] ? x[3] : x[1]; x[1] = hi_; x[3] = lo_; }
    { const unsigned hi_ = x[4] > x[6] ? x[4] : x[6], lo_ = x[4] > x[6] ? x[6] : x[4]; x[4] = hi_; x[6] = lo_; }
    { const unsigned hi_ = x[5] > x[7] ? x[5] : x[7], lo_ = x[5] > x[7] ? x[7] : x[5]; x[5] = hi_; x[7] = lo_; }
    { const unsigned hi_ = x[8] > x[10] ? x[8] : x[10], lo_ = x[8] > x[10] ? x[10] : x[8]; x[8] = hi_; x[10] = lo_; }
    { const unsigned hi_ = x[9] > x[11] ? x[9] : x[11], lo_ = x[9] > x[11] ? x[11] : x[9]; x[9] = hi_; x[11] = lo_; }
    { const unsigned hi_ = x[12] > x[14] ? x[12] : x[14], lo_ = x[12] > x[14] ? x[14] : x[12]; x[12] = hi_; x[14] = lo_; }
    { const unsigned hi_ = x[13] > x[15] ? x[13] : x[15], lo_ = x[13] > x[15] ? x[15] : x[13]; x[13] = hi_; x[15] = lo_; }
    { const unsigned hi_ = x[0] > x[1] ? x[0] : x[1], lo_ = x[0] > x[1] ? x[1] : x[0]; x[0] = hi_; x[1] = lo_; }
    { const unsigned hi_ = x[2] > x[3] ? x[2] : x[3], lo_ = x[2] > x[3] ? x[3] : x[2]; x[2] = hi_; x[3] = lo_; }
    { const unsigned hi_ = x[4] > x[5] ? x[4] : x[5], lo_ = x[4] > x[5] ? x[5] : x[4]; x[4] = hi_; x[5] = lo_; }
    { const unsigned hi_ = x[6] > x[7] ? x[6] : x[7], lo_ = x[6] > x[7] ? x[7] : x[6]; x[6] = hi_; x[7] = lo_; }
    { const unsigned hi_ = x[8] > x[9] ? x[8] : x[9], lo_ = x[8] > x[9] ? x[9] : x[8]; x[8] = hi_; x[9] = lo_; }
    { const unsigned hi_ = x[10] > x[11] ? x[10] : x[11], lo_ = x[10] > x[11] ? x[11] : x[10]; x[10] = hi_; x[11] = lo_; }
    { const unsigned hi_ = x[12] > x[13] ? x[12] : x[13], lo_ = x[12] > x[13] ? x[13] : x[12]; x[12] = hi_; x[13] = lo_; }
    { const unsigned hi_ = x[14] > x[15] ? x[14] : x[15], lo_ = x[14] > x[15] ? x[15] : x[14]; x[14] = hi_; x[15] = lo_; }
}
__device__ __forceinline__ void bmerge16_desc(unsigned (&a)[16]) {
#pragma unroll
    for (int st = 8; st >= 1; st >>= 1)
#pragma unroll
        for (int i = 0; i < 16; ++i) if ((i & st) == 0) { const unsigned hi_ = a[i] > a[i + st] ? a[i] : a[i + st], lo_ = a[i] > a[i + st] ? a[i + st] : a[i]; a[i] = hi_; a[i + st] = lo_; }
}
__device__ __forceinline__ void merge16_desc(unsigned (&a)[16], const unsigned (&b)[16]) {
#pragma unroll
    for (int i = 0; i < 16; ++i) a[i] = a[i] > b[15 - i] ? a[i] : b[15 - i];
    bmerge16_desc(a);
}
__device__ __forceinline__ void peer_route_unit(LAS char* lds, const bf16* PQ, const bf16* SUBK, unsigned char* G8, int tile32, int tid) {
    const int wid = __builtin_amdgcn_readfirstlane(tid >> 6), lane = tid & 63, r32 = lane & 31, hi = lane >> 5, hp = wid;
    LAS unsigned* lists = (LAS unsigned*)lds + wid * 1024;
    LAS v2u* ENT = (LAS v2u*)(lds + 40960);
    __syncthreads();
    { LAS v4u* hz = (LAS v4u*)(lds + 73728) + tid * 2; hz[0] = (v4u){0u, 0u, 0u, 0u}; hz[1] = (v4u){0u, 0u, 0u, 0u}; if (tid == 0) *(LAS unsigned*)(lds + 106496) = 0u; }
    const int token = tile32 * 32 + r32;
#pragma unroll 1
    for (int half = 0; half < 2; ++half) {
        bf16x8 qr[8];
        { const bf16* qp = PQ + (size_t)token * PQW + hp * 256 + half * 128 + hi * 8;
#pragma unroll
          for (int d0 = 0; d0 < 8; ++d0) qr[d0] = *(const GAS bf16x8*)(qp + d0 * 16); }
        unsigned key[4][16]; unsigned hi4 = (unsigned)hi << 2; asm volatile("" : "+v"(hi4));
        const bf16* kt0 = SUBK + ((size_t)((hp * 2 + half) * 128 + r32)) * 128 + hi * 8;
        bf16x8 fa[8];
#pragma unroll
        for (int d0 = 0; d0 < 8; ++d0) fa[d0] = *(const GAS bf16x8*)(kt0 + d0 * 16);
#pragma unroll
        for (int kg = 0; kg < 4; ++kg) { f32x16 s = f32x16{}; bf16x8 fb[8];
            if (kg < 3) {
#pragma unroll
                for (int d0 = 0; d0 < 8; ++d0) fb[d0] = *(const GAS bf16x8*)(kt0 + (size_t)(kg + 1) * 32 * 128 + d0 * 16); }
#pragma unroll
            for (int d0 = 0; d0 < 8; ++d0) s = __builtin_amdgcn_mfma_f32_32x32x16_bf16(fa[d0], qr[d0], s, 0, 0, 0);
#pragma unroll
            for (int r = 0; r < 16; ++r) { const int kidx = kg * 32 + (r & 3) + 8 * (r >> 2);
                key[kg][r] = ((f2ord(s[r]) & ~127u) | (unsigned)(127 - kidx)) ^ hi4; }
            sort16_desc(key[kg]);
            SBAR();
            if (kg < 3) {
#pragma unroll
                for (int d0 = 0; d0 < 8; ++d0) fa[d0] = fb[d0]; } }
        merge16_desc(key[0], key[1]); merge16_desc(key[2], key[3]); merge16_desc(key[0], key[2]);
        { unsigned po[16];
#pragma unroll
          for (int i = 0; i < 16; ++i) { unsigned v0, v1; pair_get(key[0][i], v0, v1); po[i] = hi ? v0 : v1; }
          merge16_desc(key[0], po); }
        if (hi == 0) { LAS v4u* lst = (LAS v4u*)(lists + (half * 32 + r32) * 16);
#pragma unroll
            for (int i = 0; i < 4; ++i) lst[i] = (v4u){key[0][4 * i], key[0][4 * i + 1], key[0][4 * i + 2], key[0][4 * i + 3]}; }
    }
    LDS_WAIT();
    unsigned ka[16], kb[16];
    { const LAS unsigned* la = lists + (0 * 32 + r32) * 16; const LAS unsigned* lb = lists + (1 * 32 + r32) * 16;
#pragma unroll
      for (int i = 0; i < 16; ++i) { ka[i] = la[i]; kb[i] = lb[i]; } }
    LDS_WAIT();
    float va[16], vb[16];
#pragma unroll
    for (int i = 0; i < 16; ++i) { va[i] = ord2f(ka[i] & ~127u); vb[i] = ord2f(kb[i] & ~127u); }
#define CK(i, j) ((f2ord(va[i] + vb[j]) & ~255u) | (unsigned)(((15 - (i)) << 4) | (15 - (j))))
    unsigned WA[16], WB[16], WC[16], WD[16];
#pragma unroll
    for (int j = 0; j < 16; ++j) WA[j] = CK(0, j);
#pragma unroll
    for (int j = 0; j < 8; ++j) { WB[j] = CK(1, j); WB[8 + j] = CK(15 - j, 0); }
    WC[0] = CK(2, 0); WC[1] = CK(2, 1); WC[2] = CK(2, 2); WC[3] = CK(2, 3); WC[4] = CK(2, 4); WC[5] = 0u; WC[6] = 0u; WC[7] = 0u; WC[8] = 0u; WC[9] = 0u; WC[10] = 0u; WC[11] = 0u;
    WC[12] = CK(3, 3); WC[13] = CK(3, 2); WC[14] = CK(3, 1); WC[15] = CK(3, 0);
    WD[0] = CK(4, 0); WD[1] = CK(4, 1); WD[2] = CK(4, 2); WD[3] = CK(5, 0); WD[4] = CK(5, 1); WD[5] = CK(6, 0); WD[6] = CK(6, 1); WD[7] = CK(7, 0); WD[8] = CK(7, 1);
    WD[9] = 0u; WD[10] = 0u; WD[11] = 0u; WD[12] = 0u; WD[13] = 0u; WD[14] = 0u; WD[15] = 0u;
#undef CK
    bmerge16_desc(WB); bmerge16_desc(WC); sort16_desc(WD);
    merge16_desc(WC, WD); merge16_desc(WA, WB); merge16_desc(WA, WC);
    v2u ent[8]; float sv[8]; float smax = -3.0e38f;
    { const LAS unsigned* la = lists + (0 * 32 + r32) * 16; const LAS unsigned* lb = lists + (1 * 32 + r32) * 16;
#pragma unroll
      for (int k = 0; k < 8; ++k) { unsigned w0 = WA[k], w1 = WA[8 + k]; asm volatile("" : "+v"(w0), "+v"(w1));
          const unsigned w = hi ? w1 : w0; const unsigned ua = la[15 - ((w >> 4) & 15u)], ub = lb[15 - (w & 15u)];
          sv[k] = ord2f(ua & ~127u) + ord2f(ub & ~127u); ent[k].y = (127u - (ua & 127u)) * 128u + (127u - (ub & 127u)); smax = fmaxf(smax, sv[k]); } }
    smax = pair_max(smax);
    float wsum = 0.f;
#pragma unroll
    for (int k = 0; k < 8; ++k) { sv[k] = __builtin_amdgcn_exp2f((sv[k] - smax) * 1.4426950408889634f); wsum += sv[k]; }
    wsum = pair_sum(wsum);
    const float rinv = 1.0f / wsum;
#pragma unroll
    for (int k = 0; k < 8; ++k) { v2u e; e.x = ent[k].y; e.y = __float_as_uint(sv[k] * rinv); ENT[r32 * 128 + hp * 16 + 8 * hi + k] = e; }
    __syncthreads();
    { const int tk = tid >> 4, s = tid & 15; const LAS v2u* row = ENT + tk * 128;
      LAS unsigned* H1 = (LAS unsigned*)(lds + 73728) + tk * 64; LAS unsigned* H2 = H1 + 2048; LAS unsigned* WL = (LAS unsigned*)(lds + 90112); LAS unsigned* wcnt = (LAS unsigned*)(lds + 106496);
      unsigned myid[8]; float myw[8]; unsigned hb[8];
#pragma unroll
      for (int k = 0; k < 8; ++k) { const v2u e = row[s * 8 + k]; myid[k] = e.x; myw[k] = __uint_as_float(e.y); hb[k] = (e.x ^ (e.x >> 11)) & 2047u;
          const unsigned bit = 1u << (hb[k] & 31u); const unsigned old = __hip_atomic_fetch_or(H1 + (hb[k] >> 5), bit, __ATOMIC_RELAXED, __HIP_MEMORY_SCOPE_WORKGROUP);
          if (old & bit) __hip_atomic_fetch_or(H2 + (hb[k] >> 5), bit, __ATOMIC_RELAXED, __HIP_MEMORY_SCOPE_WORKGROUP); }
      __syncthreads();
      unsigned char* Grow = G8 + (size_t)(tile32 * 32 + tk) * LDG8;
#pragma unroll
      for (int k = 0; k < 8; ++k) { const bool shared = (H2[hb[k] >> 5] >> (hb[k] & 31u)) & 1u;
          if (!shared) Grow[myid[k]] = (unsigned char)(pk4_fp8(myw[k] * G_SCL, 0.f, 0.f, 0.f) & 0xffu);
          else { const unsigned w = __hip_atomic_fetch_add(wcnt, 1u, __ATOMIC_RELAXED, __HIP_MEMORY_SCOPE_WORKGROUP); WL[w] = (unsigned)(tk * 128 + s * 8 + k); } }
      __syncthreads();
      const unsigned nw = *wcnt;
      for (unsigned w = (unsigned)tid; w < nw; w += NWAVES * 64) { const unsigned e0 = WL[w]; const int tk2 = (int)(e0 >> 7), o0 = (int)(e0 & 127u); const LAS v2u* row2 = ENT + tk2 * 128;
          const unsigned id = row2[o0].x; float gs = 0.f; int fo = 127;
#pragma unroll 8
          for (int o = 0; o < 128; ++o) { const v2u e = row2[o]; const bool mt = e.x == id; gs += mt ? __uint_as_float(e.y) : 0.f; fo = mt ? (o < fo ? o : fo) : fo; }
          if (fo == o0) G8[(size_t)(tile32 * 32 + tk2) * LDG8 + id] = (unsigned char)(pk4_fp8(gs * G_SCL, 0.f, 0.f, 0.f) & 0xffu); } }
}

struct Args { const float* in[21]; float* out; unsigned char* ws; };
enum { I_X = 0, I_MEM, I_NORM_MIX_G, I_W_IN, I_MOBA_QG, I_MOBA_KG, I_MOBA_OG, I_SB_OG, I_W_OUT, I_NORM_XG, I_NORM_MEMG, I_W_XQ, I_W_XKV, I_XQG, I_XKG, I_W_XO, I_NORM_FG, I_W_PQ, I_SUBK, I_U, I_V };

__global__ void __launch_bounds__(NWAVES * 64, 2) mk_fwd(Args args) {
    extern __shared__ __attribute__((aligned(16))) unsigned char lds_raw[];
    LAS unsigned char* lds = (LAS unsigned char*)lds_raw;
    volatile LAS unsigned* MISC = (volatile LAS unsigned*)(lds + MISC_OFF);
    const int tid = threadIdx.x, lane = tid & 63, wave = __builtin_amdgcn_readfirstlane(tid >> 6);
    const int G = gridDim.x, bx = blockIdx.x;
    unsigned* ctl = (unsigned*)(args.ws + WS_CTL);
    for (int u = tid; u < (LDS_BYTES - RING_BYTES) / 4; u += NWAVES * 64) ((LAS unsigned*)(lds + RING_BYTES))[u] = 0u;
    __syncthreads();
    XcdBarrier bar = xcd_barrier_post(ctl + CW_BAR, MISC + 8);

    if (tid == 0) {
#pragma unroll
        for (int i = 0; i < 21; ++i) { const unsigned long long p = (unsigned long long)args.in[i]; MISC[16 + 2 * i] = (unsigned)p; MISC[17 + 2 * i] = (unsigned)(p >> 32); }
        { const unsigned long long p = (unsigned long long)args.out; MISC[16 + 42] = (unsigned)p; MISC[17 + 42] = (unsigned)(p >> 32); }
        { const unsigned long long p = (unsigned long long)args.ws; MISC[16 + 44] = (unsigned)p; MISC[17 + 44] = (unsigned)(p >> 32); }
    }
    __syncthreads();
#define PTR(i) ((const float*)(((unsigned long long)(unsigned)__builtin_amdgcn_readfirstlane((int)MISC[17 + 2 * (i)]) << 32) | (unsigned long long)(unsigned)__builtin_amdgcn_readfirstlane((int)MISC[16 + 2 * (i)])))
#define OUTP ((float*)PTR(21))
#define WSP(off) ((bf16*)((unsigned char*)PTR(22) + (off)))
#define GW (bx * NWAVES + wave)
#define NGW (G * NWAVES)
#define GTID ((size_t)bx * (NWAVES * 64) + tid)
#define GTHREADS ((size_t)G * (NWAVES * 64))
    {
        LAS unsigned* Tl = (LAS unsigned*)lds;
        unsigned char* wsb = (unsigned char*)PTR(22);
        { const float* pW = PTR(I_W_OUT); unsigned* cm = (unsigned*)((unsigned char*)PTR(22) + WS_CMAX_WOUT);
          for (int it = bx; it < (D / 256) * (D / 256); it += G) colmax_item(pW, D, 256 * (it / (D / 256)), 256 * (it % (D / 256)), cm, (LAS f32x4*)(lds + 65536), tid); }
        { const float* pW = PTR(I_W_PQ); const float* kg = PTR(I_NORM_FG); unsigned* cm = (unsigned*)((unsigned char*)PTR(22) + WS_CMAX_WPQ);
          for (int it = bx; it < (D / 256) * (PQW / 256); it += G) colmax_item(pW, PQW, 256 * (it / (PQW / 256)), 256 * (it % (PQW / 256)), cm, (LAS f32x4*)(lds + 65536), tid, kg); }
        cvt_f32_bf16(PTR(I_SUBK), WSP(WS_SUBK), (size_t)8 * 2 * 128 * 128, GTID, GTHREADS);
        { const float* px = PTR(I_X); const float* pg = PTR(I_NORM_MIX_G); bf16* ph = WSP(WS_H);
          unsigned char* ph8 = (unsigned char*)WSP(WS_H8); float* sah = (float*)((unsigned char*)PTR(22) + WS_SA_H);
          for (int m = GW; m < M; m += NGW) rms_row_4096<true>(px + (size_t)m * D, pg, (bf16*)nullptr, ph8 + (size_t)m * LDH8, lane, sah + m); }
        { const float* px = PTR(I_MEM); const float* pg = PTR(I_NORM_MEMG); bf16* ph = WSP(WS_MEMN);
          for (int m = GW; m < NB * NMEM; m += NGW) rms_row_4096<false>(px + (size_t)m * D, pg, ph + (size_t)m * D, nullptr, lane); }
        { const float* pW = PTR(I_W_IN); unsigned* cm = (unsigned*)(wsb + WS_CMAX_WIN);
          for (int it = bx; it < 16 * 48; it += G) { const int kb = it / 48, nb = it % 48; colmax_item(pW, NPROJ, 256 * kb, 256 * nb, cm, (LAS f32x4*)(lds + 65536), tid); } }
    }
    xcd_barrier(bar);
    {
        LAS unsigned* Tl = (LAS unsigned*)lds; unsigned char* wsb = (unsigned char*)PTR(22); constexpr int NI8 = (D / 128) * (NPROJ / 256);
        transpose_matrix<true>(PTR(I_W_IN), D, NPROJ, wsb + WS_WIN8, D, 1.f, nullptr, Tl, bx, G, NI8, tid, (const unsigned*)(wsb + WS_CMAX_WIN));
    }
    xcd_barrier(bar);

    {
        pg8::Gemm g{WSP(WS_H8), WSP(WS_WIN8), M, NPROJ, D / 2, LDH8 / 2, D / 2}; pg8::StaticOrder S; S.init(M, NPROJ, G, bx);
        pg8::EpiProj E{WSP(WS_PROJ), LDP, PTR(I_MOBA_QG), PTR(I_MOBA_KG), WSP(WS_KMEAN), (LAS float*)(lds + RING_BYTES + 1024), RMS_EPS, 0,
                       (const float*)((unsigned char*)PTR(22) + WS_SA_H), (const unsigned*)((unsigned char*)PTR(22) + WS_CMAX_WIN)};
        pg8::gemm_phase<pg8::EpiProj, pg8::StaticOrder, true, true, false, true>(lds, g, S, E);
    }
    xcd_barrier(bar);

    {
        float gq = fmaxf(fabsf(PTR(I_MOBA_QG)[lane]), fabsf(PTR(I_MOBA_QG)[lane + 64])), gk = fmaxf(fabsf(PTR(I_MOBA_KG)[lane]), fabsf(PTR(I_MOBA_KG)[lane + 64]));
#pragma unroll
        for (int o = 1; o < 64; o <<= 1) { gq = fmaxf(gq, __shfl_xor(gq, o)); gk = fmaxf(gk, __shfl_xor(gk, o)); }
        const float thrB = 2.f * (11.3137085f * 1.01f * gq * gk) + 104.f;
        unsigned* qctr = (unsigned*)PTR(22) + CW_QUEUE;
        if (tid == 0) { MISC[71] = 0u; MISC[72] = xb_xcc_id() & 7u; }
        auto fetch = [&]() -> unsigned {
            unsigned st = MISC[71]; const unsigned myx = MISC[72];
            if (!(st & 1u) && (st >> 8) != 0xffu) {
                for (unsigned k = 0; k < 8u; ++k) { const unsigned q = (myx + k) & 7u; if ((st >> (8 + q)) & 1u) continue;
                    const unsigned p = atomicAdd(qctr + 64 * (1 + q), 1u);
                    if (p < 128u) { MISC[71] = st | 1u; return q * 128u + p; }
                    st |= 1u << (8 + q); } }
            MISC[71] = st & ~1u;
            const unsigned c = atomicAdd(qctr, 1u);
            return c < 1568u ? 1024u + c : 0xFFFFu; };
        unsigned nxt_tk = 0u; if (tid == 0) nxt_tk = fetch();
        for (;;) {
            __syncthreads();
            if (tid == 0) MISC[70] = nxt_tk;
            __syncthreads();
            const unsigned u = (unsigned)__builtin_amdgcn_readfirstlane((int)MISC[70]);
            if (u >= 2592u) break;
            if (tid == 0) nxt_tk = fetch();
            if (u >= 1024u && u < 1568u) {
                const int cv = (int)(u - 1024u);
                int tidc = tid; asm volatile("" : "+v"(tidc));
                LAS unsigned* Tl = (LAS unsigned*)lds; unsigned char* wsb = (unsigned char*)PTR(22);
                int it = 8 * cv;
                if (it < 2048) transpose_matrix<true>(PTR(I_V), NEXP, D, wsb + WS_VT8, LDV8, V_SCL, nullptr, Tl, it, 1, it + 8, tidc);
                else if ((it -= 2048) < 512) transpose_matrix<true>(PTR(I_W_OUT), D, D, wsb + WS_WOUT, D, 1.f, nullptr, Tl, it, 1, it + 8, tidc, (const unsigned*)(wsb + WS_CMAX_WOUT));
                else if ((it -= 512) < 256) transpose_matrix<true>(PTR(I_W_PQ), D, PQW, wsb + WS_WPQ, D, 1.f, PTR(I_NORM_FG), Tl, it, 1, it + 8, tidc, (const unsigned*)(wsb + WS_CMAX_WPQ));
                else if ((it -= 256) < 256) transpose_matrix<false>(PTR(I_W_XKV), D, 2 * XW, wsb + WS_WXKV, LDW, 1.f, nullptr, Tl, it, 1, it + 8, tidc);
                else if ((it -= 256) < 128) transpose_matrix<false>(PTR(I_W_XQ), D, XW, wsb + WS_WXQ, LDW, 1.f, PTR(I_NORM_XG), Tl, it, 1, it + 8, tidc);
                else if ((it -= 128) < 128) transpose_matrix<false>(PTR(I_W_XO), XW, D, wsb + WS_WXO, LDXO, 1.f, nullptr, Tl, it, 1, it + 8, tidc);
                else { it -= 128; const size_t e0 = (size_t)it * 65536;
                    cvt_u_fp6(PTR(I_U) + e0, wsb + WS_U8 + (e0 / D) * LDU8, LDU8, (float*)(wsb + WS_SU) + e0 / D, PTR(I_NORM_FG), 128, tidc); }
                continue;
            }
            int tida = tid; asm volatile("" : "+v"(tida));
            if (u < 1024u) { const int q = (int)(u >> 7), p = (int)(u & 127u), lvl = 15 - (p >> 3), j = p & 7, gq_ = q & 3, i_ = j & 3;
                const int hh = i_ == 0 ? gq_ : (i_ == 1 ? 15 - gq_ : (i_ == 2 ? 7 - gq_ : 8 + gq_)), bb = 2 * (q >> 2) + (j >> 2);
                moba_unit((LAS char*)lds, WSP(WS_PROJ), WSP(WS_KMEAN), WSP(WS_AO), bb, hh, lvl, thrB, tida); }
            else { const unsigned a = u - 1568u; const int bh = (int)(a & 63u), lvl = 15 - (int)((a >> 6) & 15u);
                sb_unit((LAS char*)lds, WSP(WS_PROJ), WSP(WS_AO), bh >> 4, bh & 15, lvl, tida); }
        }
    }
    xcd_barrier(bar);

    { const bf16* pa = WSP(WS_AO); unsigned char* p8 = (unsigned char*)WSP(WS_AO8); float* sa = (float*)((unsigned char*)PTR(22) + WS_SA_AO); const float* g1 = PTR(I_MOBA_OG); const float* g2 = PTR(I_SB_OG);
      int lane2 = lane; asm volatile("" : "+v"(lane2));
      for (int m = GW; m < M; m += NGW) outnorm_row(pa + (size_t)m * LDAO, p8 + (size_t)m * D, sa + m, g1, g2, lane2); }
    xcd_barrier(bar);

    {
        pg8::Gemm g{WSP(WS_AO8), WSP(WS_WOUT), M, D, D / 2, D / 2, D / 2}; pg8::StaticOrder S; S.init(M, D, G, bx);
        pg8::EpiResNorm<false, false, true> E{PTR(I_X), D, WSP(WS_H), LDH, nullptr, 0, (unsigned long long*)((unsigned char*)PTR(22) + WS_ROWSS1), 1.f, (unsigned*)((unsigned char*)PTR(22) + WS_ROWMAX1), nullptr, 0, nullptr, (const float*)((unsigned char*)PTR(22) + WS_SA_AO), (const unsigned*)((unsigned char*)PTR(22) + WS_CMAX_WOUT)};
        pg8::gemm_phase<pg8::EpiResNorm<false, false, true>, pg8::StaticOrder, true, true, false, true>(lds, g, S, E);
    }
    xcd_barrier(bar);

    if (G < 160) { const v4u z = {0u, 0u, 0u, 0u}; GAS v4u* gp = (GAS v4u*)WSP(WS_G8); const size_t n16 = (size_t)M * LDG8 / 16; const size_t gs_ = GTHREADS; for (size_t i = GTID; i < n16; i += gs_) gp[i] = z; }
    {
        pg8::Gemm g{WSP(WS_H), WSP(WS_WXQ), M, XW, D, LDH, LDW}; pg8::StaticOrder S; S.init(M, XW, G, bx);
        pg8::EpiBf16Row E{WSP(WS_XQ), XW, (const unsigned long long*)((unsigned char*)PTR(22) + WS_ROWSS1), 5.9604644775390625e-8f / 4096.f, RMS_EPS};
        pg8::gemm_phase<pg8::EpiBf16Row, pg8::StaticOrder, true, true>(lds, g, S, E);
    }
    if (G >= 160 && bx >= 144) {
        const v4u z = {0u, 0u, 0u, 0u}; GAS v4u* gp = (GAS v4u*)WSP(WS_G8); const size_t n16 = (size_t)M * LDG8 / 16;
        const size_t gs_ = (size_t)(G - 144) * (NWAVES * 64); for (size_t i = (size_t)(bx - 144) * (NWAVES * 64) + tid; i < n16; i += gs_) gp[i] = z;
    }
    {
        const int c = (G >= 160) ? bx - 128 : bx;
        if (c >= 0) {
            pg8::Gemm g{WSP(WS_MEMN), WSP(WS_WXKV), NB * NMEM, 2 * XW, D, D, LDW}; pg8::StaticOrder S; S.init(NB * NMEM, 2 * XW, G, c);
            pg8::EpiBf16<0> E{WSP(WS_KVMEM), 2 * XW, nullptr, 0, 0, 1.f};
            pg8::gemm_phase<pg8::EpiBf16<0>, pg8::StaticOrder, true, true>(lds, g, S, E);
        }
    }
    xcd_barrier(bar);

    for (int u = bx; u < 256; u += G) xattn_unit((LAS char*)lds, WSP(WS_XQ), WSP(WS_KVMEM), PTR(I_XQG), PTR(I_XKG), WSP(WS_XO), u >> 6, (u >> 4) & 3, u & 15, tid);
    xcd_barrier(bar);

    {
        pg8::Gemm g{WSP(WS_XO), WSP(WS_WXO), M, D, XW, LDXO, LDXO}; pg8::StaticOrder S; S.init(M, D, G, bx);
        pg8::EpiResNormF6 E{WSP(WS_H), LDH, WSP(WS_H), LDH, (unsigned char*)WSP(WS_H8), LDH8, (unsigned long long*)((unsigned char*)PTR(22) + WS_ROWSS2),
                            (unsigned char*)WSP(WS_H8I), D, (const unsigned*)((unsigned char*)PTR(22) + WS_ROWMAX1)};
        pg8::gemm_phase<pg8::EpiResNormF6, pg8::StaticOrder, true, true>(lds, g, S, E);
    }
    xcd_barrier(bar);

    {
        pg8::Gemm g{WSP(WS_H8I), WSP(WS_WPQ), M, PQW, D / 2, D / 2, D / 2}; pg8::StaticOrder S; S.init(M, PQW, G, bx);
        pg8::EpiBf16RowI8 E{WSP(WS_PQ), PQW, (const unsigned long long*)((unsigned char*)PTR(22) + WS_ROWSS2), 5.9604644775390625e-8f / 4096.f, RMS_EPS,
                            (const unsigned*)((unsigned char*)PTR(22) + WS_ROWMAX1), (const unsigned*)((unsigned char*)PTR(22) + WS_CMAX_WPQ)};
        pg8::gemm_phase<pg8::EpiBf16RowI8, pg8::StaticOrder, true, true, false, true>(lds, g, S, E);
    }
    xcd_barrier(bar);

    for (int u = bx; u < 512; u += G) peer_route_unit((LAS char*)lds, WSP(WS_PQ), WSP(WS_SUBK), (unsigned char*)WSP(WS_G8), u, tid);
    xcd_barrier(bar);

    {
        pg8::Gemm g{WSP(WS_H8), WSP(WS_U8), M, NEXP, D / 2, LDH8 / 2, LDU8 / 2}; pg8::StaticOrder S; S.init(M, NEXP, G, bx);
        pg8::EpiGate8 E{(unsigned char*)WSP(WS_G8), LDG8, 1.25f / 7.5f, (const unsigned long long*)((unsigned char*)PTR(22) + WS_ROWSS2), 5.9604644775390625e-8f / 4096.f, RMS_EPS,
                        (const unsigned*)((unsigned char*)PTR(22) + WS_ROWMAX1), (const float*)((unsigned char*)PTR(22) + WS_SU)};
        pg8::gemm_phase<pg8::EpiGate8, pg8::StaticOrder, true, true, false, false, true>(lds, g, S, E);
    }
    xcd_barrier(bar);

    {
        pg8::Gemm g{WSP(WS_G8), WSP(WS_VT8), M, D, NEXP / 2, LDG8 / 2, LDV8 / 2}; pg8::StaticOrder S; S.init(M, D, G, bx);
        pg8::EpiF32ResB16 E{WSP(WS_H), LDH, OUTP, D, 1.f / (G_SCL * V_SCL)};
        pg8::gemm_phase<pg8::EpiF32ResB16, pg8::StaticOrder, true, true, true>(lds, g, S, E);
    }
}

extern "C" void kernel_launch(void* const* d_in, const int* in_sizes, int n_in, void* d_out, int out_size, void* d_ws, size_t ws_size, hipStream_t stream) {
    static int grid = 0;
    if (grid == 0) {
        if (n_in != 21 || in_sizes[0] != M * D || out_size != M * D || ws_size < WS_END) { fprintf(stderr, "kernel_launch: unexpected shapes (n_in %d, in0 %d, out %d, ws %zu); nothing launched\n", n_in, n_in > 0 ? in_sizes[0] : -1, out_size, ws_size); grid = -1; return; }
        int dev = 0, cus = 0;
        if (hipGetDevice(&dev) != hipSuccess || hipDeviceGetAttribute(&cus, hipDeviceAttributeMultiprocessorCount, dev) != hipSuccess) { grid = -1; return; }
        if (hipFuncSetAttribute((const void*)mk_fwd, hipFuncAttributeMaxDynamicSharedMemorySize, LDS_BYTES) != hipSuccess) { fprintf(stderr, "kernel_launch: hipFuncSetAttribute failed\n"); grid = -1; return; }
        int per_cu = 0;
        if (hipOccupancyMaxActiveBlocksPerMultiprocessor(&per_cu, (const void*)mk_fwd, NWAVES * 64, LDS_BYTES) != hipSuccess || per_cu < 1) fprintf(stderr, "kernel_launch: occupancy query reports %d\n", per_cu);
        (void)hipGetLastError();
        grid = cus;
    }
    if (grid < 0) return;
    if (hipMemsetAsync((char*)d_ws + WS_CTL, 0, CTL_ZERO_BYTES, stream) != hipSuccess) return;
    Args a{};
    for (int i = 0; i < 21; ++i) a.in[i] = (const float*)d_in[i];
    a.out = (float*)d_out; a.ws = (unsigned char*)d_ws;
    hipLaunchKernelGGL(mk_fwd, dim3(grid), dim3(NWAVES * 64), LDS_BYTES, stream, a);
}
```
